# Optimizing an MI355X kernel written in HIP

```python
import jax, jax.numpy as jnp
from jax import lax
import numpy as np

D_MODEL = 2048
BATCH = 4
SEQ = 4096
DEPTH = 4
DEC_BATCH = 32
DEC_SEQ = 32
PAST_LEN = 4096

CHUNK = 64
Q_BLOCK = 128
N_MIXERS = 2
N_A = (DEPTH + 1) // 2
N_B = DEPTH // 2
N_HEADS = 16
QK_NOPE = 128
QK_ROPE = 64
V_HEAD = 128
Q_LORA = 512
KV_LORA = 512
ROPE_THETA = 10000.0
CONV_W = 3
D_FF = 4 * D_MODEL
EPS = 1e-6
SM_SCALE = (QK_NOPE + QK_ROPE) ** -0.5

kernel_name = "mla_shortconv_hybrid_stream_step"


def rmsnorm(x, g):
    xf = x.astype(jnp.float32)
    y = xf * lax.rsqrt(jnp.mean(xf * xf, axis=-1, keepdims=True) + EPS)
    return (y * g.astype(jnp.float32)).astype(x.dtype)


def rope(x, pos):
    half = x.shape[-1] // 2
    inv = ROPE_THETA ** (-jnp.arange(0, half, dtype=jnp.float32) / half)
    ang = pos.astype(jnp.float32)[:, None] * inv[None, :]
    shape = (pos.shape[0],) + (1,) * (x.ndim - 3) + (half,)
    cos, sin = jnp.cos(ang).reshape(shape), jnp.sin(ang).reshape(shape)
    xf = x.astype(jnp.float32)
    x1, x2 = xf[..., :half], xf[..., half:]
    return jnp.concatenate([x1 * cos - x2 * sin, x1 * sin + x2 * cos], axis=-1).astype(x.dtype)


def mla_project(h, pos, w_dq, g_q, w_uq, w_dkv, g_kv):
    b, t, _ = h.shape
    c_q = rmsnorm(h @ w_dq, g_q)
    q = (c_q @ w_uq).reshape(b, t, N_HEADS, QK_NOPE + QK_ROPE)
    q_nope, q_rope = q[..., :QK_NOPE], rope(q[..., QK_NOPE:], pos)
    kv = h @ w_dkv
    c_kv = rmsnorm(kv[..., :KV_LORA], g_kv)
    k_rope = rope(kv[..., KV_LORA:], pos)
    return q_nope, q_rope, c_kv, k_rope


def mla_block(q_nope, q_rope, q_pos, c_kv, k_rope, k_pos, w_uk, w_uv):
    q_lat = jnp.einsum('bqhn,lhn->bqhl', q_nope, w_uk)
    s = (jnp.einsum('bqhl,bkl->bhqk', q_lat, c_kv)
         + jnp.einsum('bqhr,bkr->bhqk', q_rope, k_rope)).astype(jnp.float32) * SM_SCALE
    allowed = (k_pos[None, :] // CHUNK) <= (q_pos[:, None] // CHUNK)
    s = jnp.where(allowed[None, None], s, -jnp.inf)
    p = jax.nn.softmax(s, axis=-1).astype(c_kv.dtype)
    o_lat = jnp.einsum('bhqk,bkl->bqhl', p, c_kv)
    return jnp.einsum('bqhl,lhv->bqhv', o_lat, w_uv)


def mla_prompt(q_nope, q_rope, c_kv, k_rope, w_uk, w_uv):
    b, s = q_nope.shape[:2]
    nblk = s // Q_BLOCK
    k_pos = jnp.arange(s, dtype=jnp.int32)

    def to_blocks(a):
        return a.reshape((b, nblk, Q_BLOCK) + a.shape[2:]).swapaxes(0, 1)

    def body(args):
        qn, qr, qp = args
        return mla_block(qn, qr, qp, c_kv, k_rope, k_pos, w_uk, w_uv)

    q_pos = jnp.arange(s, dtype=jnp.int32).reshape(nblk, Q_BLOCK)
    o = lax.map(body, (to_blocks(q_nope), to_blocks(q_rope), q_pos))
    return o.swapaxes(0, 1).reshape(b, s, N_HEADS, V_HEAD)


def mla_mixer(h, pos, past_c, past_r, w_dq, g_q, w_uq, w_dkv, g_kv, w_uk, w_uv, w_o):
    b, t, _ = h.shape
    q_nope, q_rope, c_kv, k_rope = mla_project(h, pos, w_dq, g_q, w_uq, w_dkv, g_kv)
    if past_c is None:
        o = mla_prompt(q_nope, q_rope, c_kv, k_rope, w_uk, w_uv)
    else:
        c_all = jnp.concatenate([past_c.astype(c_kv.dtype), c_kv], axis=1)
        r_all = jnp.concatenate([past_r.astype(k_rope.dtype), k_rope], axis=1)
        k_pos = jnp.arange(c_all.shape[1], dtype=jnp.int32)
        o = mla_block(q_nope, q_rope, pos, c_all, r_all, k_pos, w_uk, w_uv)
    return o.reshape(b, t, N_HEADS * V_HEAD) @ w_o, c_kv, k_rope


def conv_mixer(h, past_u, w_in, conv_w, w_out):
    b, t, d = h.shape
    gate_b, gate_c, v = jnp.split(h @ w_in, 3, axis=-1)
    u = gate_c * v
    if past_u is None:
        past_u = jnp.zeros((b, CONV_W - 1, d), u.dtype)
    u_pad = jnp.concatenate([past_u.astype(u.dtype), u], axis=1)
    conv = conv_w[0] * u_pad[:, 0:t]
    for k in range(1, CONV_W):
        conv = conv + conv_w[k] * u_pad[:, k:k + t]
    return (gate_b * conv) @ w_out, u_pad[:, -(CONV_W - 1):]


def trunk(x, pos, past_c, past_r, past_u, p):
    new_c, new_r, new_u = [], [], []
    for i in range(DEPTH):
        j = i // N_MIXERS
        h = rmsnorm(x, p['norm_mix'][i])
        if i % N_MIXERS == 0:
            y, c, r = mla_mixer(h, pos,
                                None if past_c is None else past_c[j],
                                None if past_r is None else past_r[j],
                                p['w_dq'][j], p['g_q'][j], p['w_uq'][j], p['w_dkv'][j],
                                p['g_kv'][j], p['w_uk'][j], p['w_uv'][j], p['w_o'][j])
            new_c.append(c)
            new_r.append(r)
        else:
            y, u = conv_mixer(h, None if past_u is None else past_u[j],
                              p['w_in'][j], p['conv_w'][j], p['w_out'][j])
            new_u.append(u)
        x = x + y
        h = rmsnorm(x, p['norm_ffn'][i])
        x = x + jnp.square(jax.nn.relu(h @ p['w_ff1'][i])) @ p['w_ff2'][i]
    return rmsnorm(x, p['norm_final']), jnp.stack(new_c), jnp.stack(new_r), jnp.stack(new_u)


def setup_inputs(seed: int = 0) -> dict:
    key = jax.random.key(seed)
    ks = jax.random.split(key, 24)
    f32 = jnp.float32

    def nrm(k, shape, scale=1.0):
        return jax.random.normal(k, shape, f32) * scale

    def gain(k, shape):
        return 1.0 + 0.02 * jax.random.normal(k, shape, f32)

    return {
        "x_prompt": nrm(ks[0], (BATCH, SEQ, D_MODEL)),
        "x_sample": nrm(ks[1], (DEC_BATCH, DEC_SEQ, D_MODEL)),
        "cache_ckv": nrm(ks[2], (N_A, DEC_BATCH, PAST_LEN, KV_LORA)),
        "cache_krope": nrm(ks[3], (N_A, DEC_BATCH, PAST_LEN, QK_ROPE)),
        "state_conv": nrm(ks[4], (N_B, DEC_BATCH, CONV_W - 1, D_MODEL)),
        "norm_mix": gain(ks[5], (DEPTH, D_MODEL)),
        "w_dq": nrm(ks[6], (N_A, D_MODEL, Q_LORA), D_MODEL ** -0.5),
        "g_q": gain(ks[7], (N_A, Q_LORA)),
        "w_uq": nrm(ks[8], (N_A, Q_LORA, N_HEADS * (QK_NOPE + QK_ROPE)), Q_LORA ** -0.5),
        "w_dkv": nrm(ks[9], (N_A, D_MODEL, KV_LORA + QK_ROPE), D_MODEL ** -0.5),
        "g_kv": gain(ks[10], (N_A, KV_LORA)),
        "w_uk": nrm(ks[11], (N_A, KV_LORA, N_HEADS, QK_NOPE), KV_LORA ** -0.5),
        "w_uv": nrm(ks[12], (N_A, KV_LORA, N_HEADS, V_HEAD), KV_LORA ** -0.5),
        "w_o": nrm(ks[13], (N_A, N_HEADS * V_HEAD, D_MODEL), (N_HEADS * V_HEAD) ** -0.5),
        "w_in": nrm(ks[14], (N_B, D_MODEL, 3 * D_MODEL), D_MODEL ** -0.5),
        "conv_w": nrm(ks[15], (N_B, CONV_W, D_MODEL), CONV_W ** -0.5),
        "w_out": nrm(ks[16], (N_B, D_MODEL, D_MODEL), D_MODEL ** -0.5),
        "norm_ffn": gain(ks[17], (DEPTH, D_MODEL)),
        "w_ff1": nrm(ks[18], (DEPTH, D_MODEL, D_FF), D_MODEL ** -0.5),
        "w_ff2": nrm(ks[19], (DEPTH, D_FF, D_MODEL), D_FF ** -0.5),
        "norm_final": gain(ks[20], (D_MODEL,)),
    }


def reference(x_prompt, x_sample, cache_ckv, cache_krope, state_conv,
              norm_mix, w_dq, g_q, w_uq, w_dkv, g_kv, w_uk, w_uv, w_o,
              w_in, conv_w, w_out, norm_ffn, w_ff1, w_ff2, norm_final):
    params = dict(norm_mix=norm_mix, w_dq=w_dq, g_q=g_q, w_uq=w_uq, w_dkv=w_dkv,
                  g_kv=g_kv, w_uk=w_uk, w_uv=w_uv, w_o=w_o, w_in=w_in,
                  conv_w=conv_w, w_out=w_out, norm_ffn=norm_ffn, w_ff1=w_ff1,
                  w_ff2=w_ff2, norm_final=norm_final)
    pos_p = jnp.arange(x_prompt.shape[1], dtype=jnp.int32)
    y_prompt, new_ckv_prompt, new_krope_prompt, new_conv_prompt = trunk(
        x_prompt, pos_p, None, None, None, params)
    pos_s = PAST_LEN + jnp.arange(x_sample.shape[1], dtype=jnp.int32)
    y_sample, new_ckv_sample, new_krope_sample, new_conv_sample = trunk(
        x_sample, pos_s, cache_ckv, cache_krope, state_conv, params)
    return (y_prompt, y_sample, new_ckv_prompt, new_krope_prompt, new_conv_prompt,
            new_ckv_sample, new_krope_sample, new_conv_sample)
```

```cpp
#include <hip/hip_runtime.h>
#include <hip/hip_bf16.h>
#include <cstdio>
#include <cstdint>

#define LAS __attribute__((address_space(3)))
#define GAS __attribute__((address_space(1)))
typedef unsigned short bf16_t;
typedef short bf16x8 __attribute__((ext_vector_type(8)));
typedef short s16x4 __attribute__((ext_vector_type(4)));
typedef float f32x2 __attribute__((ext_vector_type(2)));
typedef float f32x4 __attribute__((ext_vector_type(4)));
typedef float f32x16 __attribute__((ext_vector_type(16)));
typedef unsigned u32x2 __attribute__((ext_vector_type(2)));
typedef unsigned u32x4 __attribute__((ext_vector_type(4)));

constexpr int DM = 2048, NB = 4, SEQ = 4096, DEPTH = 4, DB = 32, DS = 32, PAST = 4096;
constexpr int NH = 16, QKN = 128, QKR = 64, VH = 128, QL_ = 512, KVL = 512, DFF = 8192;
constexpr int MP = NB * SEQ;
constexpr int MS = DB * DS;
constexpr int MT = MP + MS;
constexpr int NKEY = PAST + DS;
constexpr int KEYP = 4352;
constexpr int QLD = 640;
constexpr float EPS = 1e-6f;
constexpr float QSCALE = 0.07216878364870322f * 1.4426950408889634f;
constexpr int NPOS = NKEY;

constexpr size_t O_YP = 0;
constexpr size_t O_YS = O_YP + (size_t)MP * DM;
constexpr size_t O_CKVP = O_YS + (size_t)MS * DM;
constexpr size_t O_KRP = O_CKVP + (size_t)2 * MP * KVL;
constexpr size_t O_CONVP = O_KRP + (size_t)2 * MP * QKR;
constexpr size_t O_CKVS = O_CONVP + (size_t)2 * NB * 2 * DM;
constexpr size_t O_KRS = O_CKVS + (size_t)2 * MS * KVL;
constexpr size_t O_CONVS = O_KRS + (size_t)2 * MS * QKR;
constexpr size_t O_END = O_CONVS + (size_t)2 * DB * 2 * DM;
static_assert(O_END == 56000512ull, "d_out size");

constexpr size_t al256(size_t x) { return (x + 255) & ~(size_t)255; }
constexpr size_t WS_CTL = 0, CTL_BYTES = 1u << 20;
constexpr size_t WS_CS = WS_CTL + CTL_BYTES;
constexpr size_t WS_SSQ = al256(WS_CS + (size_t)NPOS * 64 * 4);
constexpr size_t SSQ_ONE = (size_t)MT * 32 * 4;
constexpr size_t WS_SSQCQ = WS_SSQ + 9 * SSQ_ONE;
constexpr size_t WS_SSQKV = WS_SSQCQ + (size_t)MT * 8 * 4;
constexpr size_t WS_X = al256(WS_SSQKV + (size_t)MT * 8 * 4);
constexpr size_t WS_XB = WS_X + (size_t)MT * DM * 4;
constexpr size_t WS_CQ = WS_XB + (size_t)MT * DM * 2;
constexpr size_t WS_KVRAW = WS_CQ + (size_t)MT * 512 * 2;
constexpr size_t WS_CKV = WS_KVRAW + (size_t)MT * 512 * 4;
constexpr size_t WS_KR = WS_CKV + (size_t)MP * 512 * 2;
constexpr size_t WS_QN = WS_KR + (size_t)MP * 64 * 2;
constexpr size_t WS_SLAB = WS_QN;
static_assert((size_t)8 * MS * DM * 4 <= (size_t)MT * 2048 * 2, "slabs fit QN");
constexpr size_t WS_QR = WS_QN + (size_t)MT * 2048 * 2;
constexpr size_t WS_KN = WS_QR + (size_t)MP * 1024 * 2;
constexpr size_t WS_V = WS_KN + (size_t)MT * 2048 * 2;
constexpr size_t WS_GB = WS_KN, WS_U = WS_V;
constexpr size_t WS_O = WS_V + (size_t)MT * 2048 * 2;
constexpr size_t WS_QL = WS_O + (size_t)MT * 2048 * 2;
constexpr size_t WS_OL = WS_QL + (size_t)MS * 16 * QLD * 2;
constexpr size_t WS_KC = WS_OL + (size_t)MS * 16 * 512 * 2;
constexpr size_t KC_ONE = (size_t)DB * KEYP * QLD * 2;
constexpr size_t WS_VT = WS_KC + 2 * KC_ONE;
constexpr size_t WS_LP = WS_VT;
constexpr int LPP = 72;
constexpr size_t WS_IL = WS_LP + (size_t)DB * 512 * LPP * 4;
constexpr size_t VT_ONE = (size_t)DB * 512 * KEYP * 2;
constexpr size_t WS_S = WS_VT + 2 * VT_ONE;
constexpr size_t WS_HB = WS_S;
constexpr size_t S_BYTES = (size_t)DB * 512 * KEYP * 4;
static_assert(S_BYTES >= (size_t)MT * DFF * 2, "HB overlays S");
constexpr size_t WS_P = WS_S + S_BYTES;
constexpr size_t WS_W1 = WS_P + (size_t)DB * 512 * KEYP * 2;
constexpr size_t WS_W2 = WS_W1 + (size_t)2 * 1280 * 2048 * 2;
constexpr size_t WS_W3 = WS_W2 + (size_t)2 * 3072 * 512 * 2;
constexpr size_t WS_WUK = WS_W3 + (size_t)2 * 4096 * 512 * 2;
constexpr size_t WS_W5 = WS_WUK + (size_t)2 * 512 * 2048 * 2;
constexpr size_t WS_W6 = WS_W5 + (size_t)2 * 8 * 256 * 1024 * 2;
constexpr size_t WS_W10 = WS_W6 + (size_t)2 * 2048 * 2048 * 2;
constexpr size_t WS_W9 = WS_W10 + (size_t)2 * 2048 * 2048 * 2;
constexpr size_t WS_W7 = WS_W9 + (size_t)2 * 6144 * 2048 * 2;
constexpr size_t WS_W8 = WS_W7 + (size_t)4 * 8192 * 2048 * 2;
constexpr size_t WS_END = WS_W8 + (size_t)4 * 2048 * 8192 * 2;
static_assert(WS_END <= 2147483648ull, "workspace map must fit 4 x largest tensor");

constexpr int CW_BAR = 4096, CW_SMFLAG = 12288;

__device__ __forceinline__ unsigned cvt_pk_bf16(float lo, float hi) { unsigned r; asm volatile("v_cvt_pk_bf16_f32 %0, %1, %2" : "=v"(r) : "v"(lo), "v"(hi)); return r; }
__device__ __forceinline__ float bf2f(unsigned short b) { return __uint_as_float((unsigned)b << 16); }
__device__ __forceinline__ float wave_sum(float v) {
#pragma unroll
    for (int o = 1; o < 64; o <<= 1) v += __shfl_xor(v, o);
    return v;
}
__device__ __forceinline__ float wave_max(float v) {
#pragma unroll
    for (int o = 1; o < 64; o <<= 1) v = fmaxf(v, __shfl_xor(v, o));
    return v;
}
#define LDS_WAIT() asm volatile("s_waitcnt lgkmcnt(0)" ::: "memory")
#define VM_WAIT() asm volatile("s_waitcnt vmcnt(0)" ::: "memory")

namespace pg8 {
constexpr int BM = 256, BK = 64, HALF = 128, HTB = HALF * BK * 2, STAGE_BYTES = 8 * HTB, NXCD = 8, WGM = 8;
__host__ __device__ __forceinline__ int lds_byte(int r, int c) { const int st = (r >> 4) * 2 + (c >> 5), rr = r & 15, cc = c & 31, ob = rr * 64 + cc * 2; return st * 1024 + (ob ^ (((ob >> 9) & 1) << 5)); }
__host__ __device__ __forceinline__ void stage_rc(int b, int& R, int& C) { const int st = b / 1024, sb = b % 1024, swz = sb ^ (((sb >> 9) & 1) << 5); R = (st >> 1) * 16 + swz / 64; C = (st & 1) * 32 + (swz % 64) / 2; }
__host__ __device__ __forceinline__ int perm32(int rho) { const int n = rho >> 4, i = rho & 15; return 8 * (i >> 2) + 4 * n + (i & 3); }

struct Unit { int pm, pn, z; };
struct Gemm { const bf16_t* A; const bf16_t* Bt; int lda, ldb, nt; };

struct SchedMN {
    int nM, nN, nwg, G, c, wgm; size_t astep, bstep;
    __device__ __forceinline__ void init(int nM_, int nN_, int G_, int c_, size_t astep_, size_t bstep_, int wgm_ = WGM) { nM = nM_; nN = nN_; nwg = nM * nN; G = G_; c = c_; astep = astep_; bstep = bstep_; wgm = wgm_; }
    __device__ __forceinline__ bool next(int i, Unit& u, size_t& aoff, size_t& boff, int& unt) const { return map((long)i * G + c, u, aoff, boff); }
    __device__ __forceinline__ bool map(const long L, Unit& u, size_t& aoff, size_t& boff) const {
        if (L >= nwg) return false;
        int wgid = (int)L; { const int q = nwg / NXCD, r = nwg % NXCD, xcd = wgid % NXCD, off = wgid / NXCD; wgid = (xcd < r ? xcd * (q + 1) : r * (q + 1) + (xcd - r) * q) + off; }
        const int nig = wgm * nN, gid = wgid / nig, fm = gid * wgm, gsz = (nM - fm) < wgm ? (nM - fm) : wgm;
        u.pm = fm + ((wgid % nig) % gsz); u.pn = (wgid % nig) / gsz; u.z = 0;
        aoff = (size_t)u.pm * astep; boff = (size_t)u.pn * bstep; return true;
    }
};

template <class Epi, class Sched, bool BTR = false>
__device__ __forceinline__ void gemm_phase(LAS unsigned char* lds, const Gemm g, const Sched& S, const Epi& E) {
    int tid = threadIdx.x; asm volatile("" : "+v"(tid));
    const int wid = __builtin_amdgcn_readfirstlane(tid >> 6), lane = tid & 63, wr = wid >> 2, wc = wid & 3, fr = lane & 15, fq = lane >> 4;
    int nt = g.nt; asm volatile("" : "+s"(nt));
    int nnt = nt;
    unsigned voffA[2], voffB[2];
#pragma unroll
    for (int i = 0; i < 2; ++i) { int R, C; stage_rc(tid * 16 + i * 8192, R, C); const int Rb = Epi::PERM ? ((R & ~31) + perm32(R & 31)) : R;
        voffA[i] = (unsigned)(R * g.lda + C) * 2u; voffB[i] = (unsigned)(Rb * g.ldb + C) * 2u;
        if constexpr (BTR) { const unsigned sb = (unsigned)(tid * 16 + i * 8192), row = sb >> 8, ch = ((sb >> 4) & 15u) ^ (((row & 3u) << 2) | ((row >> 2) & 3u));
            voffB[i] = (row * (unsigned)g.ldb + ch * 8u) * 2u; } }
    const size_t hstepA = (size_t)HALF * g.lda * 2, hstepB = BTR ? (size_t)HALF * 2 : (size_t)HALF * g.ldb * 2;
    const long kmulB = BTR ? (long)g.ldb : 1L;
    unsigned trb[2][2];
    if constexpr (BTR) {
#pragma unroll
        for (int n = 0; n < 2; ++n)
#pragma unroll
            for (int t = 0; t < 2; ++t) { const unsigned q = (unsigned)(lane & 15) >> 2, p = (unsigned)lane & 3u, row = 8u * (unsigned)fq + 4u * t + q, ch = 2u * (unsigned)(wc * 2 + n) + (p >> 1);
                trb[n][t] = (unsigned)(size_t)lds + 4u * HTB + 256u * row + 16u * (ch ^ (((row & 3u) << 2) | ((row >> 2) & 3u))) + 8u * (p & 1u); } }
    const unsigned ldsw = (unsigned)wid * 1024u;
    const int aoff = lds_byte(wr * 64 + fr, fq * 8), boff = lds_byte(wc * 32 + fr, fq * 8);
#define PG8_SA(b, h) (((b) * 2 + (h)) * HTB)
#define PG8_SB(b, h) ((4 + (b) * 2 + (h)) * HTB)
#define PG8_STAGE(bufoff, gbase, voff) do { _Pragma("unroll") for (int _i = 0; _i < 2; ++_i) \
        __builtin_amdgcn_global_load_lds((const unsigned*)((const char*)(gbase) + (voff)[_i]), (LAS unsigned*)(lds + (bufoff) + ldsw + _i * 8192), 16, 0, 0); } while (0)
#define PG8_LDA(dst, b, h) do { _Pragma("unroll") for (int m = 0; m < 4; ++m) _Pragma("unroll") for (int k = 0; k < 2; ++k) dst[m][k] = *(const LAS bf16x8*)(lds + PG8_SA(b, h) + aoff + m * 2048 + k * 1024); } while (0)
#define PG8_LDB(dst, b, h) do { _Pragma("unroll") for (int n = 0; n < 2; ++n) _Pragma("unroll") for (int k = 0; k < 2; ++k) dst[n][k] = *(const LAS bf16x8*)(lds + PG8_SB(b, h) + boff + n * 2048 + k * 1024); } while (0)
#define PG8_TR(dst, addr, off) asm volatile("ds_read_b64_tr_b16 %0, %1 offset:%2" : "=v"(dst) : "v"(addr), "i"(off) : "memory")
#define PG8_LDBT(T, b, h) do { _Pragma("unroll") for (int n = 0; n < 2; ++n) _Pragma("unroll") for (int k = 0; k < 2; ++k) { \
        PG8_TR(T[n][k][0], trb[n][0], ((b) * 2 + (h)) * HTB + k * 8192); PG8_TR(T[n][k][1], trb[n][1], ((b) * 2 + (h)) * HTB + k * 8192); } } while (0)
#define PG8_TIE8(T) "+v"(T[0][0][0]), "+v"(T[0][0][1]), "+v"(T[0][1][0]), "+v"(T[0][1][1]), "+v"(T[1][0][0]), "+v"(T[1][0][1]), "+v"(T[1][1][0]), "+v"(T[1][1][1])
#define PG8_MKB(B, T) do { _Pragma("unroll") for (int n = 0; n < 2; ++n) _Pragma("unroll") for (int k = 0; k < 2; ++k) \
        B[n][k] = (bf16x8){T[n][k][0][0], T[n][k][0][1], T[n][k][0][2], T[n][k][0][3], T[n][k][1][0], T[n][k][1][1], T[n][k][1][2], T[n][k][1][3]}; } while (0)
#define PG8_MMA(ai, bj, At, Bt) do { __builtin_amdgcn_s_setprio(1); _Pragma("unroll") for (int m = 0; m < 4; ++m) _Pragma("unroll") for (int n = 0; n < 2; ++n) _Pragma("unroll") for (int k = 0; k < 2; ++k) \
        acc[ai][bj][m][n] = __builtin_amdgcn_mfma_f32_16x16x32_bf16(Bt[n][k], At[m][k], acc[ai][bj][m][n], 0, 0, 0); __builtin_amdgcn_s_setprio(0); } while (0)
#define PG8_WAIT_V(n) asm volatile("s_waitcnt vmcnt(" #n ")" ::: "memory")
#define PG8_WAIT_L(n) asm volatile("s_waitcnt lgkmcnt(" #n ")" ::: "memory")
#define PG8_BAR __builtin_amdgcn_s_barrier()
#define PG8_SCHED __builtin_amdgcn_sched_barrier(0)
    Unit cur, nxt; int ui = 0; size_t uao, ubo;
    if (!S.next(0, cur, uao, ubo, nt)) return;
    long kstep = nt < 0 ? -(long)(BK * 2) : (long)(BK * 2), nkstep = (long)(BK * 2); if (nt < 0) nt = -nt;
    f32x4 acc[2][2][4][2];
#pragma unroll
    for (int a = 0; a < 2; ++a)
#pragma unroll
        for (int b = 0; b < 2; ++b)
#pragma unroll
            for (int m = 0; m < 4; ++m)
#pragma unroll
                for (int n = 0; n < 2; ++n) acc[a][b][m][n] = (f32x4){0.f, 0.f, 0.f, 0.f};
    bf16x8 At[4][2], B0[2][2], B1[2][2]; s16x4 T0[2][2][2], T1[2][2][2];
    const char* cA = (const char*)g.A + uao; const char* cB = (const char*)g.Bt + ubo;
    PG8_STAGE(PG8_SB(0, 0), cB, voffB); PG8_STAGE(PG8_SB(0, 1), cB + hstepB, voffB); PG8_STAGE(PG8_SA(0, 0), cA, voffA); PG8_STAGE(PG8_SA(0, 1), cA + hstepA, voffA);
    if (wr == 1) PG8_BAR;
    PG8_WAIT_V(2); PG8_BAR;
    PG8_STAGE(PG8_SB(1, 0), cB + kstep * kmulB, voffB); PG8_STAGE(PG8_SA(1, 0), cA + kstep, voffA); PG8_STAGE(PG8_SB(1, 1), cB + hstepB + kstep * kmulB, voffB);
    PG8_WAIT_V(6); PG8_BAR;
    for (;;) {
        const bool has_next = S.next(ui + 1, nxt, uao, ubo, nnt);
        if (has_next) { nkstep = nnt < 0 ? -(long)(BK * 2) : (long)(BK * 2); if (nnt < 0) nnt = -nnt; } else nkstep = kstep;
        const char* nA = has_next ? (const char*)g.A + uao : cA; const char* nB = has_next ? (const char*)g.Bt + ubo : cB;
        for (int t = 0; t < nt; t += 2) {
            const bool last = (t == nt - 2);
            const char* a1 = cA + (long)(t + 1) * kstep;
            const char* a2 = last ? nA : cA + (long)(t + 2) * kstep; const char* b2 = last ? nB : cB + (long)(t + 2) * kstep * kmulB;
            const long ks3 = last ? nkstep : kstep; const char* a3 = a2 + ks3; const char* b3 = b2 + ks3 * kmulB;
            if constexpr (BTR) { PG8_LDBT(T0, 0, 0); PG8_LDBT(T1, 0, 1); } else { PG8_LDB(B0, 0, 0); PG8_LDB(B1, 0, 1); }
            PG8_SCHED; PG8_LDA(At, 0, 0); PG8_STAGE(PG8_SA(1, 1), a1 + hstepA, voffA);
            PG8_WAIT_V(8);
            if constexpr (BTR) { asm volatile("s_waitcnt lgkmcnt(0)" : PG8_TIE8(T0), PG8_TIE8(T1) :: "memory"); PG8_SCHED; PG8_MKB(B0, T0); PG8_MKB(B1, T1); } else PG8_WAIT_L(0);
            PG8_BAR; PG8_MMA(0, 0, At, B0); PG8_MMA(0, 1, At, B1); PG8_BAR; PG8_SCHED;
            PG8_LDA(At, 0, 1); PG8_STAGE(PG8_SB(0, 0), b2, voffB); PG8_STAGE(PG8_SB(0, 1), b2 + hstepB, voffB); PG8_STAGE(PG8_SA(0, 0), a2, voffA);
            PG8_WAIT_V(8); PG8_WAIT_L(0); PG8_BAR; PG8_MMA(1, 0, At, B0); PG8_MMA(1, 1, At, B1); PG8_BAR; PG8_SCHED;
            if constexpr (BTR) { PG8_LDBT(T0, 1, 0); PG8_LDBT(T1, 1, 1); } else { PG8_LDB(B0, 1, 0); PG8_LDB(B1, 1, 1); }
            PG8_SCHED; PG8_LDA(At, 1, 0); PG8_STAGE(PG8_SA(0, 1), a2 + hstepA, voffA);
            PG8_WAIT_V(8);
            if constexpr (BTR) { asm volatile("s_waitcnt lgkmcnt(0)" : PG8_TIE8(T0), PG8_TIE8(T1) :: "memory"); PG8_SCHED; PG8_MKB(B0, T0); PG8_MKB(B1, T1); } else PG8_WAIT_L(0);
            PG8_BAR; PG8_MMA(0, 0, At, B0); PG8_MMA(0, 1, At, B1); PG8_BAR; PG8_SCHED;
            PG8_LDA(At, 1, 1); PG8_STAGE(PG8_SB(1, 0), b3, voffB); PG8_STAGE(PG8_SB(1, 1), b3 + hstepB, voffB); PG8_STAGE(PG8_SA(1, 0), a3, voffA);
            PG8_WAIT_V(8); PG8_WAIT_L(0); PG8_BAR; PG8_MMA(1, 0, At, B0); PG8_MMA(1, 1, At, B1); PG8_BAR; PG8_SCHED;
        }
        if (wr == 0) PG8_BAR;
        E(acc, cur, wr, wc, fr, fq);
        if (!has_next) break;
#pragma unroll
        for (int a = 0; a < 2; ++a)
#pragma unroll
            for (int b = 0; b < 2; ++b)
#pragma unroll
                for (int m = 0; m < 4; ++m)
#pragma unroll
                    for (int n = 0; n < 2; ++n) acc[a][b][m][n] = (f32x4){0.f, 0.f, 0.f, 0.f};
        cur = nxt; cA = nA; cB = nB; ++ui; nt = nnt; kstep = nkstep;
        if (wr == 1) PG8_BAR;
    }
    PG8_WAIT_V(0);
    PG8_BAR;
#undef PG8_SA
#undef PG8_SB
#undef PG8_STAGE
#undef PG8_LDA
#undef PG8_LDB
#undef PG8_TR
#undef PG8_LDBT
#undef PG8_TIE8
#undef PG8_MKB
#undef PG8_MMA
#undef PG8_WAIT_V
#undef PG8_WAIT_L
#undef PG8_BAR
#undef PG8_SCHED
}
}

namespace epi {
using pg8::Unit; using pg8::BM; using pg8::HALF;
typedef f32x4 Acc[2][2][4][2];

template <int NP> __device__ __forceinline__ float row_rstd(const float* part, int row, int fq, float inv_n) {
    float s;
    if constexpr (NP == 32) { const f32x4 a = *(const f32x4*)(part + (size_t)row * 32 + fq * 8), b = *(const f32x4*)(part + (size_t)row * 32 + fq * 8 + 4);
        s = ((a[0] + a[1]) + (a[2] + a[3])) + ((b[0] + b[1]) + (b[2] + b[3])); }
    else { const f32x2 a = *(const f32x2*)(part + (size_t)row * 8 + fq * 2); s = a[0] + a[1]; }
    s += __shfl_xor(s, 16); s += __shfl_xor(s, 32);
    return 1.0f / sqrtf(s * inv_n + EPS);
}
__device__ __forceinline__ float sq4(const f32x4 v) { return (v[0] * v[0] + v[1] * v[1]) + (v[2] * v[2] + v[3] * v[3]); }
__device__ __forceinline__ float sq0(const f32x4 a) { return (a[0] + a[1]) + (a[2] + a[3]); }
__device__ __forceinline__ u32x4 pack8(const f32x4 a, const f32x4 b) { u32x4 w; w.x = cvt_pk_bf16(a[0], a[1]); w.y = cvt_pk_bf16(a[2], a[3]); w.z = cvt_pk_bf16(b[0], b[1]); w.w = cvt_pk_bf16(b[2], b[3]); return w; }
__device__ __forceinline__ f32x4 rope4(const f32x4 v, const f32x4 cs) { return (f32x4){v[0] * cs[0] - v[1] * cs[1], v[0] * cs[1] + v[1] * cs[0], v[2] * cs[2] - v[3] * cs[3], v[2] * cs[3] + v[3] * cs[2]}; }
__device__ __forceinline__ int row_pos(int row) { return row < MP ? (row & (SEQ - 1)) : PAST + ((row - MP) & (DS - 1)); }

struct EpiResid {
    static constexpr bool PERM = true;
    bf16_t* XB; float* ssq; float* slab;
    __device__ __forceinline__ void operator()(const Acc& acc, const Unit& u, int wr, int wc, int fr, int fq) const {
        const int row0 = u.pm * BM + wr * 64 + fr, col0 = u.pn * BM + wc * 32 + 8 * fq;
        if (u.z == 0) {
#pragma unroll
        for (int ai = 0; ai < 2; ++ai)
#pragma unroll
            for (int m = 0; m < 4; ++m) { const int row = row0 + ai * HALF + m * 16;
                bf16_t* xr = XB + (size_t)row * DM + col0;
                float s = 0.f;
#pragma unroll
                for (int bj = 0; bj < 2; ++bj) { const u32x4 xo = *(const u32x4*)(xr + bj * HALF);
                    f32x4 v0 = acc[ai][bj][m][0], v1 = acc[ai][bj][m][1];
                    v0[0] += __uint_as_float(xo.x << 16); v0[1] += __uint_as_float(xo.x & 0xffff0000u); v0[2] += __uint_as_float(xo.y << 16); v0[3] += __uint_as_float(xo.y & 0xffff0000u);
                    v1[0] += __uint_as_float(xo.z << 16); v1[1] += __uint_as_float(xo.z & 0xffff0000u); v1[2] += __uint_as_float(xo.w << 16); v1[3] += __uint_as_float(xo.w & 0xffff0000u);
                    *(u32x4*)(xr + bj * HALF) = pack8(v0, v1); s += sq4(v0) + sq4(v1); }
                s += __shfl_xor(s, 16); s += __shfl_xor(s, 32);
                if (fq == 0) ssq[(size_t)row * 32 + u.pn * 4 + wc] = s; }
        } else {
            bf16_t* sl = (bf16_t*)slab + (size_t)(u.z - 1) * MS * DM;
#pragma unroll
        for (int ai = 0; ai < 2; ++ai)
#pragma unroll
            for (int m = 0; m < 4; ++m) { bf16_t* p = sl + (size_t)(row0 - MP + ai * HALF + m * 16) * DM + col0;
#pragma unroll
                for (int bj = 0; bj < 2; ++bj) *(u32x4*)(p + bj * HALF) = pack8(acc[ai][bj][m][0], acc[ai][bj][m][1]); }
        }
    }
};
struct EpiFF1 {
    static constexpr bool PERM = true;
    const float* ssq; bf16_t* HB;
    __device__ __forceinline__ void operator()(const Acc& acc, const Unit& u, int wr, int wc, int fr, int fq) const {
        const int row0 = u.pm * BM + wr * 64 + fr, col0 = u.pn * BM + wc * 32 + 8 * fq;
#pragma unroll
        for (int ai = 0; ai < 2; ++ai)
#pragma unroll
            for (int m = 0; m < 4; ++m) { const int row = row0 + ai * HALF + m * 16; const float r = row_rstd<32>(ssq, row, fq, 1.0f / DM);
#pragma unroll
                for (int bj = 0; bj < 2; ++bj) { f32x4 v0 = acc[ai][bj][m][0] * r, v1 = acc[ai][bj][m][1] * r;
#pragma unroll
                    for (int e = 0; e < 4; ++e) { const float a = fmaxf(v0[e], 0.f), b = fmaxf(v1[e], 0.f); v0[e] = a * a; v1[e] = b * b; }
                    *(u32x4*)(HB + (size_t)row * DFF + col0 + bj * HALF) = pack8(v0, v1); } }
    }
};
struct EpiW1 {
    static constexpr bool PERM = true;
    const float* ssq; const float* cs; bf16_t* CQ; float* ssqcq; float* KVRAW; float* ssqkv; bf16_t* KR; bf16_t* KC  ; float* okrp; float* okrs  ;
    __device__ __forceinline__ void operator()(const Acc& acc, const Unit& u, int wr, int wc, int fr, int fq) const {
        const int row0 = u.pm * BM + wr * 64 + fr; const int pn = u.pn;
        if (pn == 4 && wc >= 2) return;
#pragma unroll
        for (int ai = 0; ai < 2; ++ai)
#pragma unroll
            for (int m = 0; m < 4; ++m) { const int row = row0 + ai * HALF + m * 16; const float r = row_rstd<32>(ssq, row, fq, 1.0f / DM);
                if (pn < 4) { float s = 0.f; const int cl = (pn & 1) * BM + wc * 32 + 8 * fq;
#pragma unroll
                    for (int bj = 0; bj < 2; ++bj) { const f32x4 v0 = acc[ai][bj][m][0] * r, v1 = acc[ai][bj][m][1] * r; s += sq4(v0) + sq4(v1);
                        if (pn < 2) *(u32x4*)(CQ + (size_t)row * 512 + cl + bj * HALF) = pack8(v0, v1);
                        else *(u32x4*)((bf16_t*)KVRAW + (size_t)row * 512 + cl + bj * HALF) = pack8(v0, v1); }
                    s += __shfl_xor(s, 16); s += __shfl_xor(s, 32);
                    if (fq == 0) { if (pn < 2) ssqcq[(size_t)row * 8 + pn * 4 + wc] = s; else ssqkv[(size_t)row * 8 + (pn - 2) * 4 + wc] = s; } }
                else {
                    const int pos = row_pos(row), p0 = 16 * wc + 4 * fq;
                    const f32x4 c0 = *(const f32x4*)(cs + (size_t)pos * 64 + p0 * 2), c1 = *(const f32x4*)(cs + (size_t)pos * 64 + p0 * 2 + 4);
                    const f32x4 o0 = rope4(acc[ai][0][m][0] * r, c0), o1 = rope4(acc[ai][0][m][1] * r, c1);
                    const u32x4 w = pack8(o0, o1); float* of;
                    if (row < MP) { *(u32x4*)(KR + (size_t)row * 64 + 2 * p0) = w; of = okrp + (size_t)row * 64; }
                    else { const int tok = row - MP, b = tok >> 5, t = tok & 31; *(u32x4*)(KC + ((size_t)b * KEYP + PAST + t) * QLD + 512 + 2 * p0) = w; of = okrs + (size_t)tok * 64; }
                    of[p0] = o0[0]; of[p0 + 32] = o0[1]; of[p0 + 1] = o0[2]; of[p0 + 33] = o0[3];
                    of[p0 + 2] = o1[0]; of[p0 + 34] = o1[1]; of[p0 + 3] = o1[2]; of[p0 + 35] = o1[3]; } }
    }
};
struct EpiW2 {
    static constexpr bool PERM = true;
    const float* ssqcq; const float* cs; bf16_t* QN; bf16_t* QR; bf16_t* QL;
    __device__ __forceinline__ void operator()(const Acc& acc, const Unit& u, int wr, int wc, int fr, int fq) const {
        const int row0 = u.pm * BM + wr * 64 + fr; const int pn = u.pn;
#pragma unroll
        for (int ai = 0; ai < 2; ++ai)
#pragma unroll
            for (int m = 0; m < 4; ++m) { const int row = row0 + ai * HALF + m * 16; const float r = row_rstd<8>(ssqcq, row, fq, 1.0f / 512.0f) * QSCALE;
                if (pn < 8) {
#pragma unroll
                    for (int bj = 0; bj < 2; ++bj) *(u32x4*)(QN + (size_t)row * 2048 + pn * BM + bj * HALF + wc * 32 + 8 * fq) = pack8(acc[ai][bj][m][0] * r, acc[ai][bj][m][1] * r); }
                else { const int pos = row_pos(row), p0 = 16 * (wc & 1) + 4 * fq;
                    const f32x4 c0 = *(const f32x4*)(cs + (size_t)pos * 64 + p0 * 2), c1 = *(const f32x4*)(cs + (size_t)pos * 64 + p0 * 2 + 4);
#pragma unroll
                    for (int bj = 0; bj < 2; ++bj) { const int g = (pn - 8) * BM + bj * HALF + wc * 32;
                        const u32x4 w = pack8(rope4(acc[ai][bj][m][0] * r, c0), rope4(acc[ai][bj][m][1] * r, c1));
                        if (row < MP) *(u32x4*)(QR + (size_t)row * 1024 + g + 8 * fq) = w;
                        else *(u32x4*)(QL + ((size_t)(row - MP) * 16 + (g >> 6)) * QLD + 512 + (g & 63) + 8 * fq) = w; } } }
    }
};
template <class Map> struct EpiBf16 {
    static constexpr bool PERM = true;
    Map map;
    __device__ __forceinline__ void operator()(const Acc& acc, const Unit& u, int wr, int wc, int fr, int fq) const {
#pragma unroll
        for (int ai = 0; ai < 2; ++ai)
#pragma unroll
            for (int m = 0; m < 4; ++m) { bf16_t* p = map(u, ai * HALF + wr * 64 + m * 16 + fr) + wc * 32 + 8 * fq;
#pragma unroll
                for (int bj = 0; bj < 2; ++bj) *(u32x4*)(p + bj * HALF) = pack8(acc[ai][bj][m][0], acc[ai][bj][m][1]); }
    }
};
template <class Map> struct EpiBf16NP {
    static constexpr bool PERM = false;
    Map map;
    __device__ __forceinline__ void operator()(const Acc& acc, const Unit& u, int wr, int wc, int fr, int fq) const {
#pragma unroll
        for (int ai = 0; ai < 2; ++ai)
#pragma unroll
            for (int m = 0; m < 4; ++m) { bf16_t* p = map(u, ai * HALF + wr * 64 + m * 16 + fr) + wc * 32 + 4 * fq;
#pragma unroll
                for (int bj = 0; bj < 2; ++bj)
#pragma unroll
                    for (int n = 0; n < 2; ++n) { const f32x4 v = acc[ai][bj][m][n]; u32x2 w; w.x = cvt_pk_bf16(v[0], v[1]); w.y = cvt_pk_bf16(v[2], v[3]); *(u32x2*)(p + bj * HALF + 16 * n) = w; } }
    }
};
struct MapW3 { bf16_t* KN; bf16_t* V; __device__ __forceinline__ bf16_t* operator()(const Unit& u, int r) const { return (u.pn < 8 ? KN + u.pn * BM : V + (u.pn - 8) * BM) + (size_t)(u.pm * BM + r) * 2048; } };
struct MapQlat { bf16_t* QL; __device__ __forceinline__ bf16_t* operator()(const Unit& u, int r) const { return QL + ((size_t)(u.pm * BM + r) * 16 + u.z) * QLD + u.pn * BM; } };
struct MapPV { bf16_t* OL; __device__ __forceinline__ bf16_t* operator()(const Unit& u, int r) const { return OL + ((size_t)u.z * 512 + u.pm * BM + r) * 512 + u.pn * BM; } };
struct MapO2 { bf16_t* O; __device__ __forceinline__ bf16_t* operator()(const Unit& u, int r) const { return O + (size_t)(MP + u.pm * BM + r) * 2048 + u.pn * BM; } };
struct MapScores { bf16_t* S; __device__ __forceinline__ bf16_t* operator()(const Unit& u, int r) const { return S + ((size_t)u.z * 512 + u.pm * BM + r) * KEYP + u.pn * BM; } };
constexpr float SM_LIM = 96.0f;
struct EpiScoresExp {
    static constexpr bool PERM = true;
    bf16_t* P; float* LP; unsigned* flag;
    __device__ __forceinline__ void operator()(const Acc& acc, const Unit& u, int wr, int wc, int fr, int fq) const {
        const bool tail = (u.pn == 16);
        float amax = 0.f;
#pragma unroll
        for (int ai = 0; ai < 2; ++ai)
#pragma unroll
            for (int m = 0; m < 4; ++m) { const int r = ai * HALF + wr * 64 + m * 16 + fr; const size_t R = (size_t)u.z * 512 + u.pm * BM + r;
                bf16_t* p = P + R * KEYP + u.pn * BM + wc * 32 + 8 * fq; float s = 0.f;
#pragma unroll
                for (int bj = 0; bj < 2; ++bj) { f32x4 v0 = acc[ai][bj][m][0], v1 = acc[ai][bj][m][1];
                    const bool dead = tail && (bj == 1 || wc != 0);
#pragma unroll
                    for (int e = 0; e < 4; ++e) { amax = fmaxf(amax, fmaxf(fabsf(v0[e]), fabsf(v1[e]))); v0[e] = dead ? 0.f : __builtin_amdgcn_exp2f(v0[e]); v1[e] = dead ? 0.f : __builtin_amdgcn_exp2f(v1[e]); }
                    s += sq0(v0) + sq0(v1); *(u32x4*)(p + bj * HALF) = pack8(v0, v1); }
                s += __shfl_xor(s, 16); s += __shfl_xor(s, 32);
                if (fq == 0) LP[R * LPP + u.pn * 4 + wc] = s; }
        if (__any(!(amax <= SM_LIM))) { if (fr == 0 && fq == 0) __hip_atomic_store(flag, 1u, __ATOMIC_RELAXED, __HIP_MEMORY_SCOPE_AGENT); }
    }
};
struct EpiO2 {
    static constexpr bool PERM = true;
    bf16_t* O; const float* IL;
    __device__ __forceinline__ void operator()(const Acc& acc, const Unit& u, int wr, int wc, int fr, int fq) const {
#pragma unroll
        for (int ai = 0; ai < 2; ++ai)
#pragma unroll
            for (int m = 0; m < 4; ++m) { const int tok = u.pm * BM + ai * HALF + wr * 64 + m * 16 + fr; bf16_t* p = O + (size_t)(MP + tok) * 2048 + u.pn * BM + wc * 32 + 8 * fq;
#pragma unroll
                for (int bj = 0; bj < 2; ++bj) { const float il = IL[(size_t)tok * 16 + u.pn * 2 + bj]; *(u32x4*)(p + bj * HALF) = pack8(acc[ai][bj][m][0] * il, acc[ai][bj][m][1] * il); } }
    }
};
struct EpiWin {
    static constexpr bool PERM = true;
    const float* ssq; bf16_t* GB; bf16_t* U; float* ocp; float* ocs  ;
    __device__ __forceinline__ void operator()(const Acc& acc, const Unit& u, int wr, int wc, int fr, int fq) const {
        const int row0 = u.pm * BM + wr * 64 + fr; const int pn = u.pn;
#pragma unroll
        for (int ai = 0; ai < 2; ++ai)
#pragma unroll
            for (int m = 0; m < 4; ++m) { const int row = row0 + ai * HALF + m * 16; const float r = row_rstd<32>(ssq, row, fq, 1.0f / DM);
                if (pn < 8) {
#pragma unroll
                    for (int bj = 0; bj < 2; ++bj) *(u32x4*)(GB + (size_t)row * DM + pn * BM + bj * HALF + wc * 32 + 8 * fq) = pack8(acc[ai][bj][m][0] * r, acc[ai][bj][m][1] * r); }
                else { const float r2 = r * r; const int c = (pn - 8) * HALF + wc * 32 + 8 * fq;
                    const f32x4 u0 = acc[ai][0][m][0] * acc[ai][1][m][0] * r2, u1 = acc[ai][0][m][1] * acc[ai][1][m][1] * r2;
                    *(u32x4*)(U + (size_t)row * DM + c) = pack8(u0, u1);
                    float* of = nullptr;
                    if (row < MP) { const int t = row & (SEQ - 1); if (t >= SEQ - 2) of = ocp + ((size_t)(row >> 12) * 2 + (t - (SEQ - 2))) * DM; }
                    else { const int tok = row - MP, t = tok & 31; if (t >= DS - 2) of = ocs + ((size_t)(tok >> 5) * 2 + (t - (DS - 2))) * DM; }
                    if (of) { *(f32x4*)(of + c) = u0; *(f32x4*)(of + c + 4) = u1; } } }
    }
};
}

namespace att {
constexpr int NW = 8, QBLK = 32, KVBLK = 64, QB = NW * QBLK, D = 128;
constexpr int SHM_V = KVBLK * D * 2, SHM_K = KVBLK * D * 2, SHM_R = KVBLK * 64 * 2;
constexpr int OFF_V = 0, OFF_K = 2 * SHM_V, OFF_R = OFF_K + 2 * SHM_K, OFF_WS = OFF_R + 2 * SHM_R, OFF_QR = OFF_WS + NW * 64 * 4, LDS_BYTES = OFF_QR + NW * 4096;
constexpr float THR2 = 11.0f;
#define KSWZ(row, colB) ((row) * 256 + ((colB) ^ (((row) & 7) << 4)))
#define RSWZ(row, colB) ((row) * 128 + ((colB) ^ (((row) & 7) << 4)))
#define SBAR() __builtin_amdgcn_sched_barrier(0)
__device__ __forceinline__ int v_st(int k, int c) { const int kk = (k & ~0xC) | ((k & 4) << 1) | ((k & 8) >> 1); return ((kk >> 3) * 4 + (c >> 5)) * 512 + ((kk & 7) * 32 + (c & 31)) * 2; }
__device__ __forceinline__ int v_rd_base(int lane) { return ((lane & 3) << 3) | (((lane >> 2) & 3) << 6) | (((lane >> 4) & 1) << 5) | (((lane >> 5) & 1) << 8); }
constexpr int v_rd_off(int d0, int ks, int half) { return d0 * 512 + ks * 4096 + half * 2048; }
__device__ __forceinline__ int crow(int r, int hi) { return (r & 3) + 8 * (r >> 2) + 4 * hi; }

__device__ __forceinline__ void partialSM(f32x16& p0, f32x16& p1, float& m_reg, float& mn, float& alpha) {
    float pmax = p0[0];
#pragma unroll
    for (int r = 1; r < 16; ++r) pmax = fmaxf(pmax, p0[r]);
#pragma unroll
    for (int r = 0; r < 16; ++r) pmax = fmaxf(pmax, p1[r]);
    { auto rr = __builtin_amdgcn_permlane32_swap(__float_as_uint(pmax), __float_as_uint(pmax), false, false);
      pmax = fmaxf(__uint_as_float(rr[0]), __uint_as_float(rr[1])); }
    if (__builtin_expect(__all((pmax - m_reg) <= THR2), 1)) { mn = m_reg; alpha = 1.f; }
    else { mn = fmaxf(m_reg, pmax); alpha = __builtin_amdgcn_exp2f(m_reg - mn); m_reg = mn; }
#pragma unroll
    for (int r = 0; r < 16; ++r) p0[r] = p0[r] - mn;
#pragma unroll
    for (int r = 0; r < 16; ++r) p1[r] = p1[r] - mn;
#pragma unroll
    for (int r = 0; r < 16; ++r) p0[r] = __builtin_amdgcn_exp2f(p0[r]);
}
__device__ __forceinline__ void partialSM2(f32x16& p0, f32x16& p1, float& m_reg, float& alpha) {
    float pmax = p0[0];
#pragma unroll
    for (int r = 1; r < 16; ++r) pmax = fmaxf(pmax, p0[r]);
#pragma unroll
    for (int r = 0; r < 16; ++r) pmax = fmaxf(pmax, p1[r]);
    { auto rr = __builtin_amdgcn_permlane32_swap(__float_as_uint(pmax), __float_as_uint(pmax), false, false);
      pmax = fmaxf(__uint_as_float(rr[0]), __uint_as_float(rr[1])); }
    if (__builtin_expect(__all(pmax <= THR2), 1)) { alpha = 1.f; }
    else { const float d = fmaxf(pmax, 0.f); alpha = __builtin_amdgcn_exp2f(-d); m_reg += d;
#pragma unroll
        for (int r = 0; r < 16; ++r) { p0[r] -= d; p1[r] -= d; } }
#pragma unroll
    for (int r = 0; r < 16; ++r) p0[r] = __builtin_amdgcn_exp2f(p0[r]);
}
__device__ __forceinline__ void finishSM(f32x16& p0, f32x16& p1, float alpha, float& l_reg, bf16x8& pa0, bf16x8& pa1, bf16x8& pa2, bf16x8& pa3) {
#pragma unroll
    for (int r = 0; r < 16; ++r) p1[r] = __builtin_amdgcn_exp2f(p1[r]);
    float ps = 0;
#pragma unroll
    for (int r = 0; r < 16; ++r) ps += p0[r];
#pragma unroll
    for (int r = 0; r < 16; ++r) ps += p1[r];
    { auto rr = __builtin_amdgcn_permlane32_swap(__float_as_uint(ps), __float_as_uint(ps), false, false);
      ps = __uint_as_float(rr[0]) + __uint_as_float(rr[1]); }
    l_reg = l_reg * alpha + ps;
#define PK4(P, B_, OUT) do { unsigned a0 = cvt_pk_bf16(P[B_+0], P[B_+1]), a1 = cvt_pk_bf16(P[B_+2], P[B_+3]);                          \
        unsigned b0 = cvt_pk_bf16(P[B_+4], P[B_+5]), b1 = cvt_pk_bf16(P[B_+6], P[B_+7]);                                             \
        auto r0 = __builtin_amdgcn_permlane32_swap(a0, b0, false, false); auto r1 = __builtin_amdgcn_permlane32_swap(a1, b1, false, false); \
        u32x4 w = {r0[0], r1[0], r0[1], r1[1]}; OUT = *reinterpret_cast<bf16x8*>(&w); } while (0)
    PK4(p0, 0, pa0); PK4(p0, 8, pa1); PK4(p1, 0, pa2); PK4(p1, 8, pa3);
#undef PK4
}
template <int KB>
__device__ __forceinline__ void qkt(f32x16& p0, f32x16& p1, const char* lds, int r32, int hi, const bf16x8* qr, const char* qrl, bool act, float cinit) {
    if (!act) { const float NEG = -__builtin_inff();
#pragma unroll
        for (int r = 0; r < 16; ++r) { p0[r] = NEG; p1[r] = NEG; } return; }
#pragma unroll
    for (int r = 0; r < 16; ++r) { p0[r] = cinit; p1[r] = cinit; }
    const char* kb[4];
#pragma unroll
    for (int dd = 0; dd < 4; ++dd) kb[dd] = lds + OFF_K + KB * SHM_K + KSWZ(r32, (dd * 16 + hi * 8) * 2);
#pragma unroll
    for (int d0 = 0; d0 < 8; ++d0) { const char* a = kb[d0 & 3] + (d0 >> 2) * 128;
        bf16x8 b0 = *reinterpret_cast<const bf16x8*>(a);
        bf16x8 b1 = *reinterpret_cast<const bf16x8*>(a + 32 * 256);
        p0 = __builtin_amdgcn_mfma_f32_32x32x16_bf16(b0, qr[d0], p0, 0, 0, 0);
        p1 = __builtin_amdgcn_mfma_f32_32x32x16_bf16(b1, qr[d0], p1, 0, 0, 0); }
#pragma unroll
    for (int dd = 0; dd < 4; ++dd) { const char* a = lds + OFF_R + KB * SHM_R + RSWZ(r32, (dd * 16 + hi * 8) * 2);
        bf16x8 b0 = *reinterpret_cast<const bf16x8*>(a);
        bf16x8 b1 = *reinterpret_cast<const bf16x8*>(a + 32 * 128);
        const bf16x8 qf = *reinterpret_cast<const bf16x8*>(qrl + dd * 1024);
        p0 = __builtin_amdgcn_mfma_f32_32x32x16_bf16(b0, qf, p0, 0, 0, 0);
        p1 = __builtin_amdgcn_mfma_f32_32x32x16_bf16(b1, qf, p1, 0, 0, 0); }
}
template <int VB>
__device__ __forceinline__ void pv_tile(f32x16* o, int vb0, bf16x8 pa0, bf16x8 pa1, bf16x8 pa2, bf16x8 pa3, bool act) {
    if (!act) return;
#define TRRD(dst, off) asm volatile("ds_read_b64_tr_b16 %0, %1 offset:%2" : "=&v"(dst) : "v"(vb0), "i"(off) : "memory")
#define PV_D0(d0) do { s16x4 l0, l1, l2, l3, h0, h1, h2, h3; constexpr int b_ = OFF_V + VB * SHM_V + v_rd_off(d0, 0, 0);   \
        TRRD(l0, b_); TRRD(h0, b_ + 2048); TRRD(l1, b_ + 4096); TRRD(h1, b_ + 6144); TRRD(l2, b_ + 8192); TRRD(h2, b_ + 10240); TRRD(l3, b_ + 12288); TRRD(h3, b_ + 14336); \
        asm volatile("s_waitcnt lgkmcnt(0)" ::: "memory"); SBAR();                                                              \
        o[d0] = __builtin_amdgcn_mfma_f32_32x32x16_bf16(pa0, (bf16x8){l0[0], l0[1], l0[2], l0[3], h0[0], h0[1], h0[2], h0[3]}, o[d0], 0, 0, 0);   \
        o[d0] = __builtin_amdgcn_mfma_f32_32x32x16_bf16(pa1, (bf16x8){l1[0], l1[1], l1[2], l1[3], h1[0], h1[1], h1[2], h1[3]}, o[d0], 0, 0, 0);   \
        o[d0] = __builtin_amdgcn_mfma_f32_32x32x16_bf16(pa2, (bf16x8){l2[0], l2[1], l2[2], l2[3], h2[0], h2[1], h2[2], h2[3]}, o[d0], 0, 0, 0);   \
        o[d0] = __builtin_amdgcn_mfma_f32_32x32x16_bf16(pa3, (bf16x8){l3[0], l3[1], l3[2], l3[3], h3[0], h3[1], h3[2], h3[3]}, o[d0], 0, 0, 0); } while (0)
    PV_D0(0); PV_D0(1); PV_D0(2); PV_D0(3);
#undef PV_D0
#undef TRRD
}
struct Tensors { const bf16_t* QN; const bf16_t* QR; const bf16_t* KN; const bf16_t* KR; const bf16_t* V; bf16_t* O; };
#define PK4(P, B_, OUT) do { unsigned a0 = cvt_pk_bf16(P[B_+0], P[B_+1]), a1 = cvt_pk_bf16(P[B_+2], P[B_+3]);                          \
        unsigned b0 = cvt_pk_bf16(P[B_+4], P[B_+5]), b1 = cvt_pk_bf16(P[B_+6], P[B_+7]);                                             \
        auto r0 = __builtin_amdgcn_permlane32_swap(a0, b0, false, false); auto r1 = __builtin_amdgcn_permlane32_swap(a1, b1, false, false); \
        u32x4 w = {r0[0], r1[0], r0[1], r1[1]}; OUT = *reinterpret_cast<bf16x8*>(&w); } while (0)
template <int KB> __device__ __forceinline__ bf16x8 kfrag(const char* lds, int r32, int hi, int g) {
    if (g < 16) { const int d0 = g >> 1; const char* a = lds + OFF_K + KB * SHM_K + KSWZ(r32, ((d0 & 3) * 16 + hi * 8) * 2) + (d0 >> 2) * 128 + (g & 1) * 32 * 256; return *reinterpret_cast<const bf16x8*>(a); }
    const int dd = (g - 16) >> 1; const char* a = lds + OFF_R + KB * SHM_R + RSWZ(r32, (dd * 16 + hi * 8) * 2) + (g & 1) * 32 * 128; return *reinterpret_cast<const bf16x8*>(a);
}
template <int KB> __device__ __forceinline__ void phase_a(f32x16& x0, f32x16& x1, f32x16& y0, f32x16& y1, float& l_reg, float alY, bf16x8& pa0, bf16x8& pa1, bf16x8& pa2, bf16x8& pa3,
                                                            const char* lds, int r32, int hi, const bf16x8* qr, const char* qrl, bool act, float cinit) {
    if (!act) cinit = -__builtin_inff();
#pragma unroll
    for (int r = 0; r < 16; ++r) { x0[r] = cinit; x1[r] = cinit; }
    bf16x8 kf[26]; bf16x8 qf[4]; float sacc = 0.f;
    kf[0] = kfrag<KB>(lds, r32, hi, 0); kf[1] = kfrag<KB>(lds, r32, hi, 1);
#pragma unroll
    for (int g = 0; g < 24; ++g) {
        if (g + 2 < 24) kf[g + 2] = kfrag<KB>(lds, r32, hi, g + 2);
        if (g >= 14 && g < 22 && (g & 1) == 0) qf[(g - 14) >> 1] = *reinterpret_cast<const bf16x8*>(qrl + ((g - 14) >> 1) * 1024);
        if (g < 16) { if (g & 1) x1 = __builtin_amdgcn_mfma_f32_32x32x16_bf16(kf[g], qr[g >> 1], x1, 0, 0, 0); else x0 = __builtin_amdgcn_mfma_f32_32x32x16_bf16(kf[g], qr[g >> 1], x0, 0, 0, 0);
            y0[g] = __builtin_amdgcn_exp2f(y0[g]); y1[g] = __builtin_amdgcn_exp2f(y1[g]); sacc += y0[g]; sacc += y1[g]; }
        else { if (g & 1) x1 = __builtin_amdgcn_mfma_f32_32x32x16_bf16(kf[g], qf[(g - 16) >> 1], x1, 0, 0, 0); else x0 = __builtin_amdgcn_mfma_f32_32x32x16_bf16(kf[g], qf[(g - 16) >> 1], x0, 0, 0, 0);
            if (g == 16) PK4(y0, 0, pa0); if (g == 18) PK4(y0, 8, pa1); if (g == 20) PK4(y1, 0, pa2); if (g == 22) PK4(y1, 8, pa3); }
        SBAR();
    }
    { auto rr = __builtin_amdgcn_permlane32_swap(__float_as_uint(sacc), __float_as_uint(sacc), false, false); sacc = __uint_as_float(rr[0]) + __uint_as_float(rr[1]); }
    l_reg = l_reg * alY + sacc;
}
__device__ __forceinline__ void finish_tail(f32x16& y0, f32x16& y1, float& l_reg, float alY, bf16x8& pa0, bf16x8& pa1, bf16x8& pa2, bf16x8& pa3) {
    float sacc = 0.f;
#pragma unroll
    for (int r = 0; r < 16; ++r) { y0[r] = __builtin_amdgcn_exp2f(y0[r]); y1[r] = __builtin_amdgcn_exp2f(y1[r]); sacc += y0[r]; sacc += y1[r]; }
    PK4(y0, 0, pa0); PK4(y0, 8, pa1); PK4(y1, 0, pa2); PK4(y1, 8, pa3);
    { auto rr = __builtin_amdgcn_permlane32_swap(__float_as_uint(sacc), __float_as_uint(sacc), false, false); sacc = __uint_as_float(rr[0]) + __uint_as_float(rr[1]); }
    l_reg = l_reg * alY + sacc;
}
template <int VB, bool WITH_MAX> __device__ __forceinline__ void phase_b(f32x16* o, int vb0, bf16x8 pa0, bf16x8 pa1, bf16x8 pa2, bf16x8 pa3, f32x16& x0, f32x16& x1, float& m_reg, float& alpha) {
#define TRRD(dst, off) asm volatile("ds_read_b64_tr_b16 %0, %1 offset:%2" : "=&v"(dst) : "v"(vb0), "i"(off) : "memory")
#define PVG(d0) do { s16x4 l0, l1, l2, l3, h0, h1, h2, h3; constexpr int b_ = OFF_V + VB * SHM_V + v_rd_off(d0, 0, 0);   \
        TRRD(l0, b_); TRRD(h0, b_ + 2048); TRRD(l1, b_ + 4096); TRRD(h1, b_ + 6144); TRRD(l2, b_ + 8192); TRRD(h2, b_ + 10240); TRRD(l3, b_ + 12288); TRRD(h3, b_ + 14336); \
        asm volatile("s_waitcnt lgkmcnt(0)" ::: "memory"); SBAR();                                                              \
        o[d0] = __builtin_amdgcn_mfma_f32_32x32x16_bf16(pa0, (bf16x8){l0[0], l0[1], l0[2], l0[3], h0[0], h0[1], h0[2], h0[3]}, o[d0], 0, 0, 0);   \
        o[d0] = __builtin_amdgcn_mfma_f32_32x32x16_bf16(pa1, (bf16x8){l1[0], l1[1], l1[2], l1[3], h1[0], h1[1], h1[2], h1[3]}, o[d0], 0, 0, 0);   \
        o[d0] = __builtin_amdgcn_mfma_f32_32x32x16_bf16(pa2, (bf16x8){l2[0], l2[1], l2[2], l2[3], h2[0], h2[1], h2[2], h2[3]}, o[d0], 0, 0, 0);   \
        o[d0] = __builtin_amdgcn_mfma_f32_32x32x16_bf16(pa3, (bf16x8){l3[0], l3[1], l3[2], l3[3], h3[0], h3[1], h3[2], h3[3]}, o[d0], 0, 0, 0); } while (0)
    PVG(0);
    float pmax = 0.f;
    if constexpr (WITH_MAX) {
        pmax = x0[0];
#pragma unroll
        for (int r = 1; r < 16; ++r) pmax = fmaxf(pmax, x0[r]);
#pragma unroll
        for (int r = 0; r < 16; ++r) pmax = fmaxf(pmax, x1[r]);
    }
    SBAR(); PVG(1);
    if constexpr (WITH_MAX) { auto rr = __builtin_amdgcn_permlane32_swap(__float_as_uint(pmax), __float_as_uint(pmax), false, false); pmax = fmaxf(__uint_as_float(rr[0]), __uint_as_float(rr[1])); }
    SBAR(); PVG(2); SBAR(); PVG(3);
    alpha = 1.f;
    if constexpr (WITH_MAX) {
        if (__builtin_expect(!__all(pmax <= THR2), 0)) { const float d = fmaxf(pmax, 0.f); alpha = __builtin_amdgcn_exp2f(-d); m_reg += d;
#pragma unroll
            for (int r = 0; r < 16; ++r) { x0[r] -= d; x1[r] -= d; } }
    }
#undef PVG
#undef TRRD
}
__device__ __forceinline__ void attn_block(const Tensors& T, int b, int h, int qb, char* lds) {
    int tid = threadIdx.x; asm volatile("" : "+v"(tid));
    const int wid = __builtin_amdgcn_readfirstlane(tid >> 6), lane = tid & 63, r32 = lane & 31, hi = lane >> 5;
    const size_t base = (size_t)b * SEQ;
    const int q0 = qb * QB, NT = q0 / KVBLK + 4, qlo = q0 + wid * QBLK;
    float* ws = (float*)(lds + OFF_WS) + wid * 64; float* li_l = ws, * al_l = ws + 32;
    float m_reg = -1e30f, l_reg = 0; f32x16 o[4] = {};
    const int vb0 = (int)(uintptr_t)lds + v_rd_base(lane);
    unsigned ko[2], vo[2], ro;
#pragma unroll
    for (int jj = 0; jj < 2; ++jj) { const int ofs = (jj * 8 + wid) * 1024 + lane * 16;
        { const int row = ofs >> 8, colB = (ofs & 255) ^ ((row & 7) << 4); ko[jj] = (unsigned)(row * 2048 + (colB >> 1)); }
        { const int sub = ofs >> 9, within = ofs & 511, kk = ((sub >> 2) << 3) | (within >> 6), k = (kk & ~0xC) | ((kk & 4) << 1) | ((kk & 8) >> 1), c = (sub & 3) * 32 + ((within & 63) >> 1); vo[jj] = (unsigned)(k * 2048 + c); } }
    { const int ofs = wid * 1024 + lane * 16, row = ofs >> 7, colB = (ofs & 127) ^ ((row & 7) << 4); ro = (unsigned)(row * 64 + (colB >> 1)); }
    const bf16_t* Kh = T.KN + base * 2048 + h * 128; const bf16_t* Vh = T.V + base * 2048 + h * 128; const bf16_t* Rh = T.KR + base * 64;
    LAS unsigned char* l3 = (LAS unsigned char*)lds;
#define DMA_K(t, bf) do { const bf16_t* kp_ = Kh + (size_t)(t) * KVBLK * 2048; const bf16_t* rp_ = Rh + (size_t)(t) * KVBLK * 64;                                      \
        __builtin_amdgcn_global_load_lds((const unsigned*)(kp_ + ko[0]), (LAS unsigned*)(l3 + OFF_K + (bf) * SHM_K + wid * 1024), 16, 0, 0);                                 \
        __builtin_amdgcn_global_load_lds((const unsigned*)(kp_ + ko[1]), (LAS unsigned*)(l3 + OFF_K + (bf) * SHM_K + (8 + wid) * 1024), 16, 0, 0);                           \
        __builtin_amdgcn_global_load_lds((const unsigned*)(rp_ + ro), (LAS unsigned*)(l3 + OFF_R + (bf) * SHM_R + wid * 1024), 16, 0, 0); } while (0)
#define DMA_V(t, bf) do { const bf16_t* vp_ = Vh + (size_t)(t) * KVBLK * 2048;                                                                                           \
        __builtin_amdgcn_global_load_lds((const unsigned*)(vp_ + vo[0]), (LAS unsigned*)(l3 + OFF_V + (bf) * SHM_V + wid * 1024), 16, 0, 0);                                 \
        __builtin_amdgcn_global_load_lds((const unsigned*)(vp_ + vo[1]), (LAS unsigned*)(l3 + OFF_V + (bf) * SHM_V + (8 + wid) * 1024), 16, 0, 0); } while (0)
#define SYNC() do { asm volatile("s_waitcnt vmcnt(0) lgkmcnt(0)" ::: "memory"); __syncthreads(); } while (0)
#define RESC(a) do { if (__any((a) < 1.f)) { if (hi == 0) al_l[r32] = (a); asm volatile("s_waitcnt lgkmcnt(0)" ::: "memory");              \
                     for (int d_ = 0; d_ < 4; ++d_) for (int r = 0; r < 16; ++r) o[d_][r] *= al_l[crow(r, hi)]; } } while (0)
#define ACT(t) ((t) * KVBLK <= qlo)
    bf16x8 qr[8]; char* qrl = lds + OFF_QR + wid * 4096 + lane * 16;
    { const size_t qrow = base + q0 + wid * QBLK + r32;
#pragma unroll
      for (int d0 = 0; d0 < 8; ++d0) qr[d0] = *(const bf16x8*)(T.QN + qrow * 2048 + h * 128 + d0 * 16 + hi * 8);
#pragma unroll
      for (int d0 = 0; d0 < 4; ++d0) *(bf16x8*)(qrl + d0 * 1024) = *(const bf16x8*)(T.QR + qrow * 1024 + h * 64 + d0 * 16 + hi * 8); }
    DMA_K(0, 0); SYNC();
    f32x16 pA0, pA1, pB0, pB1; float alA = 1.f, alB = 1.f; bf16x8 pa0, pa1, pa2, pa3;
    DMA_K(1, 1); DMA_V(0, 0);
    { float mn_; qkt<0>(pA0, pA1, lds, r32, hi, qr, qrl, true, 0.f);
      float pmax = pA0[0];
#pragma unroll
      for (int r = 1; r < 16; ++r) pmax = fmaxf(pmax, pA0[r]);
#pragma unroll
      for (int r = 0; r < 16; ++r) pmax = fmaxf(pmax, pA1[r]);
      { auto rr = __builtin_amdgcn_permlane32_swap(__float_as_uint(pmax), __float_as_uint(pmax), false, false); pmax = fmaxf(__uint_as_float(rr[0]), __uint_as_float(rr[1])); }
      m_reg = pmax; mn_ = pmax;
#pragma unroll
      for (int r = 0; r < 16; ++r) { pA0[r] -= mn_; pA1[r] -= mn_; } }
    SYNC();
#define STEP(X0, X1, alX, Y0, Y1, alY, t, KB, VB) do {                                                                         \
        if ((t) + 1 < NT) DMA_K((t) + 1, (KB) ^ 1); DMA_V(t, (VB) ^ 1); SBAR();                                               \
        phase_a<KB>(X0, X1, Y0, Y1, l_reg, alY, pa0, pa1, pa2, pa3, lds, r32, hi, qr, qrl, ACT(t), -m_reg); SBAR();           \
        phase_b<VB, true>(o, vb0, pa0, pa1, pa2, pa3, X0, X1, m_reg, alX); SBAR();                                             \
        RESC(alX); SYNC(); } while (0)
    for (int t = 1; t + 1 < NT; t += 2) {
        STEP(pB0, pB1, alB, pA0, pA1, alA, t, 1, 0);
        STEP(pA0, pA1, alA, pB0, pB1, alB, t + 1, 0, 1);
    }
    STEP(pB0, pB1, alB, pA0, pA1, alA, NT - 1, 1, 0);
    finish_tail(pB0, pB1, l_reg, alB, pa0, pa1, pa2, pa3); SBAR();
    { float dm_, da_; phase_b<1, false>(o, vb0, pa0, pa1, pa2, pa3, pB0, pB1, dm_ = 0.f, da_); }
    if (hi == 0) li_l[r32] = l_reg; asm volatile("s_waitcnt lgkmcnt(0)" ::: "memory");
    float rli[16];
#pragma unroll
    for (int r = 0; r < 16; ++r) rli[r] = __builtin_amdgcn_rcpf(li_l[crow(r, hi)]);
    bf16_t* Ow = T.O + (base + q0 + wid * QBLK) * 2048 + h * 128;
    __syncthreads();
    { bf16_t* stg = (bf16_t*)(lds + OFF_V) + wid * 4096;
#pragma unroll
      for (int r = 0; r < 16; ++r) { const int orow = crow(r, hi);
#pragma unroll
          for (int d0 = 0; d0 < 4; ++d0) { const float v = o[d0][r] * rli[r]; stg[orow * 128 + d0 * 32 + r32] = (bf16_t)(cvt_pk_bf16(v, 0.f) & 0xffffu); } }
      asm volatile("s_waitcnt lgkmcnt(0)" ::: "memory");
#pragma unroll
      for (int i = 0; i < 8; ++i) { const int row = i * 4 + (lane >> 4), ch = lane & 15; const u32x4 v = *(const u32x4*)(stg + row * 128 + ch * 8); *(u32x4*)(Ow + (size_t)row * 2048 + ch * 8) = v; } }
    __syncthreads();
#undef DMA_K
#undef DMA_V
#undef SYNC
#undef RESC
#undef ACT
#undef STEP
}
#undef PK4
#undef KSWZ
#undef RSWZ
#undef SBAR
}

namespace thin {
struct Ctx { int lane, wave, gw, ngw, gt, ngt; LAS unsigned char* lds; };

struct TJob { const float* W; const float* gain; bf16_t* dst; int K, N, ldd, kind; };
__device__ __forceinline__ bf16_t* dst_ptr(const TJob& J, int s) {
    int row = s, koff = 0;
    switch (J.kind) {
        case 1: row = s < 512 ? 512 + s : 1024 + 2 * ((s - 512) & 31) + ((s - 512) >> 5); break;
        case 2: { const int h = s / 192, d = s - h * 192; row = d < 128 ? h * 128 + d : 2048 + h * 64 + 2 * ((d - 128) & 31) + ((d - 128) >> 5); } break;
        case 3: koff = ((s & 255) >> 7) * 512; break;
        case 4: if (s >= 4096) { const int t = (s - 4096) >> 7, r = (s - 4096) & 127; row = 2048 + 256 * t + 128 + r; } else if (s >= 2048) { const int t = (s - 2048) >> 7, r = (s - 2048) & 127; row = 2048 + 256 * t + r; } break;
        default: break;
    }
    return J.dst + (size_t)row * J.ldd + koff;
}
__device__ __forceinline__ void titem_load(const TJob& J, int item, int lane, f32x4 (&v)[8]) {
    const int nblk = J.N / 32, kb = item / nblk, nb = item - kb * nblk, k0 = 64 * kb, s0 = 32 * nb; const int rs = lane >> 3, c4 = (lane & 7) * 4;
#pragma unroll
    for (int i = 0; i < 8; ++i) v[i] = *(const f32x4*)(J.W + (size_t)(k0 + i * 8 + rs) * J.N + s0 + c4);
}
__device__ __forceinline__ void titem_finish(const TJob& J, int item, LAS float* scr, int lane, const f32x4 (&v)[8]) {
    const int nblk = J.N / 32, kb = item / nblk, nb = item - kb * nblk, k0 = 64 * kb, s0 = 32 * nb; const int rs = lane >> 3, c4 = (lane & 7) * 4;
#pragma unroll
    for (int i = 0; i < 8; ++i) { const int kk = i * 8 + rs; const float gv = J.gain ? J.gain[k0 + kk] : 1.0f;
#pragma unroll
        for (int e = 0; e < 4; ++e) scr[kk * 33 + c4 + e] = v[i][e] * gv; }
    LDS_WAIT(); asm volatile("" ::: "memory");
    const int c = lane & 7;
#pragma unroll
    for (int j = 0; j < 4; ++j) { const int n = (lane >> 3) + 8 * j; const LAS float* s = scr + (8 * c) * 33 + n;
        u32x4 o; o.x = cvt_pk_bf16(s[0 * 33], s[1 * 33]); o.y = cvt_pk_bf16(s[2 * 33], s[3 * 33]); o.z = cvt_pk_bf16(s[4 * 33], s[5 * 33]); o.w = cvt_pk_bf16(s[6 * 33], s[7 * 33]);
        *(u32x4*)(dst_ptr(J, s0 + n) + k0 + 8 * c) = o; }
    LDS_WAIT(); asm volatile("" ::: "memory");
}
__device__ __forceinline__ void transpose_item(const TJob& J, int item, LAS float* scr, int lane) { f32x4 v[8]; titem_load(J, item, lane, v); titem_finish(J, item, scr, lane, v); }
__device__ __forceinline__ void zero_win(const Ctx& C, bf16_t* base, int rows, size_t ld, int ncols) {
    const int cpr = ncols / 8; const long total = (long)rows * cpr;
    for (long i = C.gt; i < total; i += C.ngt) { const long r = i / cpr; const int c = (int)(i - r * cpr); *(u32x4*)(base + r * ld + c * 8) = (u32x4){0u, 0u, 0u, 0u}; }
}
__device__ __forceinline__ void x_to_bf16(const Ctx& C, const float* xp, const float* xs, bf16_t* XB, float* ssq) {
    for (int row = C.gw; row < MT; row += C.ngw) {
        const float* src = row < MP ? xp + (size_t)row * DM : xs + (size_t)(row - MP) * DM;
        float s = 0.f;
#pragma unroll
        for (int j = 0; j < 8; ++j) { const f32x4 v = *(const f32x4*)(src + 4 * C.lane + 256 * j); s += epi::sq4(v);
            u32x2 w; w.x = cvt_pk_bf16(v[0], v[1]); w.y = cvt_pk_bf16(v[2], v[3]); *(u32x2*)(XB + (size_t)row * DM + 4 * C.lane + 256 * j) = w; }
        s = wave_sum(s);
        if (C.lane < 32) ssq[(size_t)row * 32 + C.lane] = C.lane == 0 ? s : 0.f;
    }
}
__device__ __forceinline__ void cs_table(const Ctx& C, float* cs) {
    for (int i = C.gt; i < NPOS * 32; i += C.ngt) { const int pos = i >> 5, p = i & 31;
        const float inv = powf(10000.0f, -(float)p / 32.0f); const float ang = (float)pos * inv; float sn, cn; sincosf(ang, &sn, &cn);
        cs[(size_t)i * 2] = cn; cs[(size_t)i * 2 + 1] = sn; }
}
__device__ __forceinline__ void citem_load(const float* ckv, int item, int lane, f32x4 (&v)[8]) {
    const int db = item & 15, kt = (item >> 4) & 63, jb = item >> 10;
    const float* src = ckv + ((size_t)jb * PAST + kt * 64) * 512 + db * 32; const int rs = lane >> 3, c4 = (lane & 7) * 4;
#pragma unroll
    for (int i = 0; i < 8; ++i) v[i] = *(const f32x4*)(src + (size_t)(i * 8 + rs) * 512 + c4);
}
__device__ __forceinline__ void citem_finish(bf16_t* KC, bf16_t* VT, int item, LAS float* scr, int lane, const f32x4 (&v)[8]) {
    const int db = item & 15, kt = (item >> 4) & 63, jb = item >> 10; const int rs = lane >> 3, c4 = (lane & 7) * 4;
#pragma unroll
    for (int i = 0; i < 8; ++i) { const int kk = i * 8 + rs;
#pragma unroll
        for (int e = 0; e < 4; ++e) scr[kk * 33 + c4 + e] = v[i][e]; }
    LDS_WAIT(); asm volatile("" ::: "memory");
    const int c = lane & 7;
    bf16_t* vt = VT + (size_t)jb * 512 * KEYP + (size_t)(db * 32) * KEYP + kt * 64;
#pragma unroll
    for (int j = 0; j < 4; ++j) { const int n = (lane >> 3) + 8 * j; const LAS float* s = scr + (8 * c) * 33 + n;
        u32x4 o; o.x = cvt_pk_bf16(s[0 * 33], s[1 * 33]); o.y = cvt_pk_bf16(s[2 * 33], s[3 * 33]); o.z = cvt_pk_bf16(s[4 * 33], s[5 * 33]); o.w = cvt_pk_bf16(s[6 * 33], s[7 * 33]);
        *(u32x4*)(vt + (size_t)n * KEYP + 8 * c) = o; }
    const int kq = lane & 3;
#pragma unroll
    for (int j = 0; j < 4; ++j) { const int key = (lane >> 2) + 16 * j; const LAS float* s = scr + key * 33 + 8 * kq;
        u32x4 o; o.x = cvt_pk_bf16(s[0], s[1]); o.y = cvt_pk_bf16(s[2], s[3]); o.z = cvt_pk_bf16(s[4], s[5]); o.w = cvt_pk_bf16(s[6], s[7]);
        *(u32x4*)(KC + ((size_t)jb * KEYP + kt * 64 + key) * QLD + db * 32 + 8 * kq) = o; }
    LDS_WAIT(); asm volatile("" ::: "memory");
}
__device__ __forceinline__ void cache_item(const float* ckv, bf16_t* KC, bf16_t* VT, int item, LAS float* scr, int lane) { f32x4 v[8]; citem_load(ckv, item, lane, v); citem_finish(KC, VT, item, scr, lane, v); }
__device__ __forceinline__ void cache_convert(const Ctx& C, const float* ckv, bf16_t* KC) {
    const long NR = (long)2 * DB * PAST;
    for (long r0 = C.gw; r0 < NR; r0 += 4L * C.ngw) { f32x4 a[4], b[4];
#pragma unroll
        for (int k = 0; k < 4; ++k) { const long r = r0 + (long)k * C.ngw; if (r < NR) { const float* src = ckv + r * 512 + 8 * C.lane; a[k] = *(const f32x4*)src; b[k] = *(const f32x4*)(src + 4); } }
#pragma unroll
        for (int k = 0; k < 4; ++k) { const long r = r0 + (long)k * C.ngw; if (r < NR) { const long jb = r >> 12; const int key = (int)(r & (PAST - 1));
            *(u32x4*)(KC + ((size_t)jb * KEYP + key) * QLD + 8 * C.lane) = epi::pack8(a[k], b[k]); } } }
}
__device__ __forceinline__ void krope_convert(const Ctx& C, const float* ckr, bf16_t* KC) {
    const long total = (long)2 * DB * PAST * 8;
    for (long i = C.gt; i < total; i += C.ngt) { const int c = (int)(i & 7); const long key = i >> 3; const long jb = key >> 12; const int k = (int)(key & (PAST - 1));
        const float* src = ckr + key * 64; const f32x4 a = *(const f32x4*)(src + 4 * c), b = *(const f32x4*)(src + 32 + 4 * c);
        u32x4 o; o.x = cvt_pk_bf16(a[0], b[0]); o.y = cvt_pk_bf16(a[1], b[1]); o.z = cvt_pk_bf16(a[2], b[2]); o.w = cvt_pk_bf16(a[3], b[3]);
        *(u32x4*)(KC + ((size_t)jb * KEYP + k) * QLD + 512 + 8 * c) = o; }
}
__device__ __forceinline__ void ckv_norm(const Ctx& C, const float* KVRAW, const float* ssqkv, const float* gkv, float* ockp, float* ocks, bf16_t* CKV, bf16_t* KC) {
    for (int row = C.gw; row < MT; row += C.ngw) {
        const f32x4 pa = *(const f32x4*)(ssqkv + (size_t)row * 8), pb = *(const f32x4*)(ssqkv + (size_t)row * 8 + 4);
        const float s = ((pa[0] + pa[1]) + (pa[2] + pa[3])) + ((pb[0] + pb[1]) + (pb[2] + pb[3]));
        const float r = 1.0f / sqrtf(s * (1.0f / 512.0f) + EPS);
#pragma unroll
        for (int j = 0; j < 2; ++j) { const int col = 4 * C.lane + 256 * j;
            const u32x2 rw = *(const u32x2*)((const bf16_t*)KVRAW + (size_t)row * 512 + col);
            const f32x4 v = (f32x4){__uint_as_float(rw.x << 16), __uint_as_float(rw.x & 0xffff0000u), __uint_as_float(rw.y << 16), __uint_as_float(rw.y & 0xffff0000u)} * r * *(const f32x4*)(gkv + col);
            u32x2 w; w.x = cvt_pk_bf16(v[0], v[1]); w.y = cvt_pk_bf16(v[2], v[3]);
            if (row < MP) { *(f32x4*)(ockp + (size_t)row * 512 + col) = v; *(u32x2*)(CKV + (size_t)row * 512 + col) = w; }
            else { const int tok = row - MP, b = tok >> 5, t = tok & 31; *(f32x4*)(ocks + (size_t)tok * 512 + col) = v;
                *(u32x2*)(KC + ((size_t)b * KEYP + PAST + t) * QLD + col) = w; } }
    }
}
__device__ __forceinline__ void softmax_rows(const Ctx& C, const bf16_t* S, bf16_t* P) {
    for (int row = C.gw; row < DB * 512; row += C.ngw) {
        const bf16_t* sp = S + (size_t)row * KEYP + 8 * C.lane; float v[9][8]; float mx = -__builtin_inff();
#pragma unroll
        for (int i = 0; i < 9; ++i) { if (i < 8 || C.lane < 4) { const u32x4 w = *(const u32x4*)(sp + 512 * i);
#pragma unroll
                for (int e = 0; e < 4; ++e) { v[i][2 * e] = __uint_as_float(w[e] << 16); v[i][2 * e + 1] = __uint_as_float(w[e] & 0xffff0000u); mx = fmaxf(mx, fmaxf(v[i][2 * e], v[i][2 * e + 1])); } }
            else {
#pragma unroll
                for (int e = 0; e < 8; ++e) v[i][e] = 0.f; } }
        mx = wave_max(mx); float l = 0.f;
#pragma unroll
        for (int i = 0; i < 9; ++i) { if (i < 8 || C.lane < 4) {
#pragma unroll
                for (int e = 0; e < 8; ++e) { v[i][e] = __builtin_amdgcn_exp2f(v[i][e] - mx); l += v[i][e]; } } }
        l = wave_sum(l); const float il = 1.0f / l;
        bf16_t* pp = P + (size_t)row * KEYP + 8 * C.lane;
#pragma unroll
        for (int i = 0; i < 9; ++i) { if (i < 8 || C.lane < 32) { u32x4 w;
#pragma unroll
                for (int e = 0; e < 4; ++e) w[e] = cvt_pk_bf16(v[i][2 * e] * il, v[i][2 * e + 1] * il);
                *(u32x4*)(pp + 512 * i) = w; } }
    }
}
__device__ __forceinline__ void rowsum_inv(const Ctx& C, const float* LP, float* IL, bool exact_ran) {
    for (int row = C.gw; row < DB * 512; row += C.ngw) {
        float s = LP[(size_t)row * LPP + C.lane] + (C.lane < 4 ? LP[(size_t)row * LPP + 64 + C.lane] : 0.f);
        s = wave_sum(s);
        if (C.lane == 0) IL[row] = exact_ran ? 1.0f : 1.0f / s; }
}
__device__ __forceinline__ void unpack8(const u32x4 w, float (&f)[8]) {
#pragma unroll
    for (int e = 0; e < 4; ++e) { f[2 * e] = __uint_as_float(w[e] << 16); f[2 * e + 1] = __uint_as_float(w[e] & 0xffff0000u); }
}
__device__ __forceinline__ void conv_pass(const Ctx& C, const bf16_t* GB, const bf16_t* U, const float* cw  , const float* st  , bf16_t* A2) {
    const long total = (long)MT * 256;
    for (long i = C.gt; i < total; i += C.ngt) { const int row = (int)(i >> 8), c = (int)(i & 255) * 8;
        float g[8], u0[8], u1[8], u2[8];
        unpack8(*(const u32x4*)(GB + (size_t)row * DM + c), g); unpack8(*(const u32x4*)(U + (size_t)row * DM + c), u2);
        int t; const float* s0 = nullptr;
        if (row < MP) t = row & (SEQ - 1); else { const int tok = row - MP; t = tok & 31; s0 = st + (size_t)(tok >> 5) * 2 * DM + c; }
        if (t >= 1) unpack8(*(const u32x4*)(U + (size_t)(row - 1) * DM + c), u1);
        else if (s0) { const f32x4 a = *(const f32x4*)(s0 + DM), b = *(const f32x4*)(s0 + DM + 4);
#pragma unroll
            for (int e = 0; e < 4; ++e) { u1[e] = a[e]; u1[4 + e] = b[e]; } }
        else {
#pragma unroll
            for (int e = 0; e < 8; ++e) u1[e] = 0.f; }
        if (t >= 2) unpack8(*(const u32x4*)(U + (size_t)(row - 2) * DM + c), u0);
        else if (s0) { const float* h = s0 + (size_t)t * DM; const f32x4 a = *(const f32x4*)(h), b = *(const f32x4*)(h + 4);
#pragma unroll
            for (int e = 0; e < 4; ++e) { u0[e] = a[e]; u0[4 + e] = b[e]; } }
        else {
#pragma unroll
            for (int e = 0; e < 8; ++e) u0[e] = 0.f; }
        float o[8];
#pragma unroll
        for (int e = 0; e < 8; ++e) o[e] = g[e] * (cw[c + e] * u0[e] + cw[DM + c + e] * u1[e] + cw[2 * DM + c + e] * u2[e]);
        u32x4 w; w.x = cvt_pk_bf16(o[0], o[1]); w.y = cvt_pk_bf16(o[2], o[3]); w.z = cvt_pk_bf16(o[4], o[5]); w.w = cvt_pk_bf16(o[6], o[7]);
        *(u32x4*)(A2 + (size_t)row * DM + c) = w; }
}
__device__ __forceinline__ void resid_finalize(const Ctx& C, const float* slab_, bf16_t* XB, float* ssq) {
    const bf16_t* slab = (const bf16_t*)slab_;
    for (int task = C.gw; task < MS * 2; task += C.ngw) { const int tok = task >> 1, half = task & 1, row = MP + tok; float s = 0.f;
#pragma unroll
        for (int j = 0; j < 2; ++j) { const int col = half * 1024 + 8 * C.lane + 512 * j; const u32x4 xo = *(const u32x4*)(XB + (size_t)row * DM + col);
            f32x4 v0 = (f32x4){__uint_as_float(xo.x << 16), __uint_as_float(xo.x & 0xffff0000u), __uint_as_float(xo.y << 16), __uint_as_float(xo.y & 0xffff0000u)};
            f32x4 v1 = (f32x4){__uint_as_float(xo.z << 16), __uint_as_float(xo.z & 0xffff0000u), __uint_as_float(xo.w << 16), __uint_as_float(xo.w & 0xffff0000u)};
            u32x4 p[8];
#pragma unroll
            for (int k = 0; k < 8; ++k) p[k] = *(const u32x4*)(slab + ((size_t)k * MS + tok) * DM + col);
#pragma unroll
            for (int k = 0; k < 8; ++k) {
                v0 += (f32x4){__uint_as_float(p[k].x << 16), __uint_as_float(p[k].x & 0xffff0000u), __uint_as_float(p[k].y << 16), __uint_as_float(p[k].y & 0xffff0000u)};
                v1 += (f32x4){__uint_as_float(p[k].z << 16), __uint_as_float(p[k].z & 0xffff0000u), __uint_as_float(p[k].w << 16), __uint_as_float(p[k].w & 0xffff0000u)}; }
            *(u32x4*)(XB + (size_t)row * DM + col) = epi::pack8(v0, v1); s += epi::sq4(v0) + epi::sq4(v1); }
        s = wave_sum(s);
        if (C.lane < 16) ssq[(size_t)row * 32 + half * 16 + C.lane] = C.lane == 0 ? s : 0.f; }
}
__device__ __forceinline__ void final_norm(const Ctx& C, const bf16_t* XB, const float* ssq, const float* g, float* yp, float* ys) {
    for (int row = C.gw; row < MT; row += C.ngw) {
        float s = C.lane < 32 ? ssq[(size_t)row * 32 + C.lane] : 0.f; s = wave_sum(s);
        const float r = 1.0f / sqrtf(s * (1.0f / DM) + EPS);
        float* dst = row < MP ? yp + (size_t)row * DM : ys + (size_t)(row - MP) * DM;
#pragma unroll
        for (int j = 0; j < 4; ++j) { const int col = 8 * C.lane + 512 * j; const u32x4 w = *(const u32x4*)(XB + (size_t)row * DM + col);
            const f32x4 a = (f32x4){__uint_as_float(w.x << 16), __uint_as_float(w.x & 0xffff0000u), __uint_as_float(w.y << 16), __uint_as_float(w.y & 0xffff0000u)};
            const f32x4 b = (f32x4){__uint_as_float(w.z << 16), __uint_as_float(w.z & 0xffff0000u), __uint_as_float(w.w << 16), __uint_as_float(w.w & 0xffff0000u)};
            *(f32x4*)(dst + col) = a * r * *(const f32x4*)(g + col); *(f32x4*)(dst + col + 4) = b * r * *(const f32x4*)(g + col + 4); }
    }
}
}

#define XB_TMO      128
#define XB_XCNT(j)  (256  + 64 * (j))
#define XB_XSUB(j)  (1280 + 64 * (j))
#define XB_XGEN(j)  (2304 + 64 * (j))
#define XB_TOP      3328
#define XB_TOPGEN   3392
#define XCD_BAR_WORDS 3456
#define XB_SPIN_CAP (1u << 18)

__device__ __forceinline__ unsigned xb_ld(unsigned* p)              { return __hip_atomic_load(p, __ATOMIC_RELAXED, __HIP_MEMORY_SCOPE_AGENT); }
__device__ __forceinline__ unsigned xb_add(unsigned* p, unsigned v) { return __hip_atomic_fetch_add(p, v, __ATOMIC_RELAXED, __HIP_MEMORY_SCOPE_AGENT); }
__device__ __forceinline__ unsigned xb_xcc_id() { return (unsigned)__builtin_amdgcn_s_getreg((3 << 11) | 20) & 0xFu; }
#define XB_SPIN(cond, bar) do { unsigned _sp = 0; while (cond) { __builtin_amdgcn_s_sleep(1); \
    if ((++_sp & 255u) == 0u) { if (xb_ld(&(bar)[XB_TMO])) break; if (_sp > XB_SPIN_CAP) { atomicAdd(&(bar)[XB_TMO], 1u); break; } } } } while (0)

struct XcdBarrier {
    unsigned* bar; unsigned x;
    volatile LAS unsigned* st;
};

__device__ __forceinline__ XcdBarrier xcd_barrier_post(unsigned* bar, volatile LAS unsigned* st) {
    XcdBarrier b; b.bar = bar; b.x = xb_xcc_id(); b.st = st;
    if (threadIdx.x == 0) (void)xb_add(&bar[XB_XCNT(b.x)], 1u);
    return b;
}
__device__ __forceinline__ void xcd_barrier_complete(unsigned* bar, unsigned x, unsigned& nloc, unsigned& nx) {
    const unsigned G = gridDim.x * gridDim.y * gridDim.z;
    unsigned sum, cnt, mine, sp = 0u;
    for (;;) {
        sum = 0u; cnt = 0u; mine = 0u;
#pragma unroll
        for (unsigned j = 0; j < 16; ++j) { const unsigned c = xb_ld(&bar[XB_XCNT(j)]); sum += c; cnt += (c > 0u) ? 1u : 0u; mine = (j == x) ? c : mine; }
        if (sum == G) break;
        __builtin_amdgcn_s_sleep(1);
        if ((++sp & 255u) == 0u) { if (xb_ld(&bar[XB_TMO])) break; if (sp > XB_SPIN_CAP) { atomicAdd(&bar[XB_TMO], 1u); break; } }
    }
    nloc = mine > 0u ? mine : 1u; nx = cnt > 0u ? cnt : 1u;
}

__device__ __forceinline__ void xcd_barrier(const XcdBarrier& b) {
    asm volatile("s_waitcnt vmcnt(0)" ::: "memory");
    __syncthreads();
    if (threadIdx.x == 0) {
        unsigned* bar = b.bar;
        __builtin_amdgcn_s_waitcnt(0);
        unsigned nloc = b.st[0], nx = b.st[1];
        if (nloc == 0u) { xcd_barrier_complete(bar, b.x, nloc, nx); b.st[0] = nloc; b.st[1] = nx; }
        const unsigned old = xb_add(&bar[XB_XSUB(b.x)], 1u);
        const unsigned gen = old / nloc;
        if (old + 1u == (gen + 1u) * nloc) {
            __builtin_amdgcn_fence(__ATOMIC_RELEASE, "agent");
            asm volatile("s_waitcnt vmcnt(0)" ::: "memory");
            const unsigned og = xb_add(&bar[XB_TOP], 1u);
            const unsigned tg = og / nx;
            if (og + 1u == (tg + 1u) * nx) xb_add(&bar[XB_TOPGEN], 1u);
            else XB_SPIN(xb_ld(&bar[XB_TOPGEN]) == tg, bar);
            __builtin_amdgcn_fence(__ATOMIC_ACQUIRE, "agent");
            xb_add(&bar[XB_XGEN(b.x)], 1u);
            asm volatile("s_waitcnt vmcnt(0)" ::: "memory");
        } else {
            XB_SPIN(xb_ld(&bar[XB_XGEN(b.x)]) == gen, bar);
            __builtin_amdgcn_fence(__ATOMIC_ACQUIRE, "agent");
            asm volatile("s_waitcnt vmcnt(0)" ::: "memory");
        }
    }
    __syncthreads();
}

constexpr int NWAVES = 8;
constexpr int RING_BYTES = 131072, MISC_OFF = RING_BYTES + 320, LDS_BYTES = 147456;
constexpr int N_PHASES = 38;

struct Args {
    const float *x_prompt, *x_sample, *cache_ckv, *cache_krope, *state_conv, *norm_mix, *w_dq, *g_q, *w_uq, *w_dkv, *g_kv, *w_uk, *w_uv, *w_o, *w_in, *conv_w, *w_out, *norm_ffn, *w_ff1, *w_ff2, *norm_final;
    float* out; unsigned char* ws; int ph_lo, ph_hi;
};

struct SchedQlat {
    int G, c;
    __device__ __forceinline__ bool next(int i, pg8::Unit& u, size_t& aoff, size_t& boff, int& unt) const { const int L = i * G + c; if (L >= 128) return false;
        u.z = L >> 3; u.pm = (L >> 1) & 3; u.pn = L & 1; aoff = ((size_t)(MP + u.pm * 256) * 2048 + u.z * 128) * 2; boff = ((size_t)(u.pn * 256) * 2048 + u.z * 128) * 2; return true; }
};
struct SchedScores {
    int G, c;
    __device__ __forceinline__ bool next(int i, pg8::Unit& u, size_t& aoff, size_t& boff, int& unt) const { const int L = i * G + c; if (L >= DB * 34) return false;
        u.z = L / 34; const int r = L - u.z * 34; u.pm = r / 17; u.pn = r - u.pm * 17;
        aoff = ((size_t)(u.z * 512 + u.pm * 256) * QLD) * 2; boff = ((size_t)(u.z * KEYP + u.pn * 256) * QLD) * 2; return true; }
};
struct SchedPV {
    int G, c;
    __device__ __forceinline__ bool next(int i, pg8::Unit& u, size_t& aoff, size_t& boff, int& unt) const { int L = i * G + c; if (L >= DB * 4) return false;
        if (G == 256) { const int x = c & 7, s = c >> 3; L = ((x + 8 * (s >> 1)) << 1) | (s & 1); }
        u.z = L >> 2; u.pm = (L >> 1) & 1; u.pn = L & 1;
        aoff = ((size_t)(u.z * 512 + u.pm * 256) * KEYP) * 2; boff = ((size_t)u.z * KEYP * QLD + u.pn * 256) * 2; return true; }
};
struct SchedO2 {
    int G, c;
    __device__ __forceinline__ bool next(int i, pg8::Unit& u, size_t& aoff, size_t& boff, int& unt) const { const int L = i * G + c; if (L >= 32) return false;
        u.z = 0; u.pm = L >> 3; u.pn = L & 7; aoff = ((size_t)(u.pm * 256) * 8192 + u.pn * 1024) * 2; boff = ((size_t)(u.pn * 256) * 1024) * 2; return true; }
};


struct SchedResid {
    pg8::SchedMN P; int G, c, nt8, L0; size_t astep, bstep; bool krev;
    __device__ __forceinline__ void init(int G_, int c_, int lda, int ldb, int nt, bool krev_, int L0_ = 0) { G = G_; c = c_; krev = krev_; L0 = L0_; nt8 = nt / 8; astep = (size_t)256 * lda * 2; bstep = (size_t)256 * ldb * 2; P.init(MP / 256, 8, G_, c_, astep, bstep, lda > 2048 ? 4 : 8); }
    __device__ __forceinline__ bool next(int i, pg8::Unit& u, size_t& aoff, size_t& boff, int& unt) const {
        const int L = i * G + c + L0;
        if (L < 512) { unt = nt8 * 8; const bool ok = P.map(L, u, aoff, boff); if (krev && (i & 1) == 0) { aoff += (size_t)(nt8 * 8 - 1) * 128; boff += (size_t)(nt8 * 8 - 1) * 128; unt = -unt; } return ok; }
        const int s = L - 512; if (s >= 256) return false;
        const int ks = s & 7; u.pn = (s >> 3) & 7; u.pm = 64 + (s >> 6); u.z = 1 + ks; unt = nt8;
        aoff = (size_t)u.pm * astep + (size_t)ks * nt8 * 128; boff = (size_t)u.pn * bstep + (size_t)ks * nt8 * 128; return true; }
};
struct SchedEarlyMix {
    pg8::SchedMN P; int c2;
    __device__ __forceinline__ void init(int G_, int bx) { c2 = bx - 128; P.init(MP / 256, 8, G_, bx, (size_t)256 * 2048 * 2, (size_t)256 * 2048 * 2); }
    __device__ __forceinline__ bool next(int i, pg8::Unit& u, size_t& aoff, size_t& boff, int& unt) const { if (c2 < 0 || i >= 2) return false; return P.map((long)i * 128 + c2, u, aoff, boff); }
};

__device__ __forceinline__ const Args& opq_args() { auto p = __builtin_amdgcn_kernarg_segment_ptr(); asm volatile("" : "+s"(p)); return *(const Args*)p; }
#define WSP(T, OFF) ((T*)(ws + (OFF)))
#define CS WSP(float, WS_CS)
#define SSQ WSP(float, WS_SSQ)
#define SSQCQ WSP(float, WS_SSQCQ)
#define SSQKV WSP(float, WS_SSQKV)
#define X WSP(float, WS_X)
#define XB WSP(bf16_t, WS_XB)
#define CQ WSP(bf16_t, WS_CQ)
#define KVRAW WSP(float, WS_KVRAW)
#define CKV WSP(bf16_t, WS_CKV)
#define KR WSP(bf16_t, WS_KR)
#define QN WSP(bf16_t, WS_QN)
#define QR WSP(bf16_t, WS_QR)
#define KN WSP(bf16_t, WS_KN)
#define VV WSP(bf16_t, WS_V)
#define GB WSP(bf16_t, WS_GB)
#define UU WSP(bf16_t, WS_U)
#define OB WSP(bf16_t, WS_O)
#define QL WSP(bf16_t, WS_QL)
#define OL WSP(bf16_t, WS_OL)
#define KC WSP(bf16_t, WS_KC)
#define VT WSP(bf16_t, WS_VT)
#define SS WSP(float, WS_S)
#define HB WSP(bf16_t, WS_HB)
#define PP WSP(bf16_t, WS_P)
#define W1 WSP(bf16_t, WS_W1)
#define W2 WSP(bf16_t, WS_W2)
#define W3 WSP(bf16_t, WS_W3)
#define WUK WSP(bf16_t, WS_WUK)
#define W5 WSP(bf16_t, WS_W5)
#define W6 WSP(bf16_t, WS_W6)
#define W10 WSP(bf16_t, WS_W10)
#define W9 WSP(bf16_t, WS_W9)
#define W7 WSP(bf16_t, WS_W7)
#define W8 WSP(bf16_t, WS_W8)

__global__ void __launch_bounds__(NWAVES * 64, 2) mk_fwd(Args args_) {
    extern __shared__ __attribute__((aligned(16))) unsigned char lds_raw[];
    LAS unsigned char* lds = (LAS unsigned char*)lds_raw;
    volatile LAS unsigned* MISC = (volatile LAS unsigned*)(lds + MISC_OFF);
    const int tid = threadIdx.x;
    const int G0 = gridDim.x, bx0 = blockIdx.x;
    unsigned* ctl = (unsigned*)(args_.ws + WS_CTL);
    for (int u = tid; u < (LDS_BYTES - RING_BYTES) / 4; u += NWAVES * 64) ((LAS unsigned*)(lds + RING_BYTES))[u] = 0u;
    __syncthreads();
    const int lo = args_.ph_lo, hi = args_.ph_hi;
    const bool use_bar = (hi - lo) > 1;
    XcdBarrier bar; bar.bar = ctl + CW_BAR; bar.x = 0; bar.st = nullptr;
    if (use_bar) bar = xcd_barrier_post(ctl + CW_BAR, MISC + 8);

    int ph = 0;
#ifndef SITE_MASK
#define SITE_MASK 0xffffffffu
#endif
#define SITE(k) (((SITE_MASK) >> (k)) & 1u)
#ifndef REPEAT_MASK
#define REPEAT_MASK 0u
#endif
#define REPS(k) (1 + (int)(((REPEAT_MASK) >> (k)) & 1u) * REPEAT_N)
#ifndef REPEAT_N
#define REPEAT_N 1
#endif
#define PH_ON() (lo <= ph && ph < hi)
#define ssq_mix (SSQ + (size_t)(2 * i) * MT * 32)
#define ssq_ffn (SSQ + (size_t)(2 * i + 1) * MT * 32)
#define ssq_next (SSQ + (size_t)(2 * i + 2) * MT * 32)
#define KCj (KC + (size_t)j * DB * KEYP * QLD)
#define VTj (VT + (size_t)j * DB * 512 * KEYP)
#define CTX_LOCALS int tid_ = threadIdx.x; asm volatile("" : "+v"(tid_)); thin::Ctx C; C.lane = tid_ & 63; C.wave = __builtin_amdgcn_readfirstlane(tid_ >> 6); C.gw = bx * NWAVES + C.wave; C.ngw = G * NWAVES; C.gt = bx * (NWAVES * 64) + tid_; C.ngt = G * NWAVES * 64; C.lds = lds
#define SITE_LOCALS int G = G0, bx = bx0; asm volatile("" : "+s"(G), "+s"(bx)); const Args& args = opq_args(); unsigned char* const ws = args.ws; float* const out = args.out; (void)ws; (void)out
#define PH_END() do { if (use_bar && lo <= ph && ph + 1 < hi) xcd_barrier(bar); ++ph; } while (0)

    if (SITE(0) && PH_ON()) for (int rep_ = 0; rep_ < REPS(0); ++rep_) { SITE_LOCALS; CTX_LOCALS; const int lane = C.lane, wave = C.wave;
        LAS float* scr = (LAS float*)(lds + wave * 16384);
        thin::cache_convert(C, args.cache_ckv, KC);
        thin::krope_convert(C, args.cache_krope, KC);
        for (int jr = 0; jr < 26; ++jr) { const int job = 25 - jr;
            thin::TJob J; J.gain = nullptr; J.kind = 0;
            if (job < 14) { const int j = job / 7, k = job - j * 7;
                switch (k) {
                    case 0: J.W = args.w_dq + (size_t)j * 2048 * 512; J.K = 2048; J.N = 512; J.gain = args.norm_mix + (size_t)(2 * j) * DM; J.dst = W1 + (size_t)j * 1280 * 2048; J.ldd = 2048; break;
                    case 1: J.W = args.w_dkv + (size_t)j * 2048 * 576; J.K = 2048; J.N = 576; J.gain = args.norm_mix + (size_t)(2 * j) * DM; J.dst = W1 + (size_t)j * 1280 * 2048; J.ldd = 2048; J.kind = 1; break;
                    case 2: J.W = args.w_uq + (size_t)j * 512 * 3072; J.K = 512; J.N = 3072; J.gain = args.g_q + (size_t)j * 512; J.dst = W2 + (size_t)j * 3072 * 512; J.ldd = 512; J.kind = 2; break;
                    case 3: J.W = args.w_uk + (size_t)j * 512 * 2048; J.K = 512; J.N = 2048; J.dst = W3 + (size_t)j * 4096 * 512; J.ldd = 512; break;
                    case 4: J.W = args.w_uv + (size_t)j * 512 * 2048; J.K = 512; J.N = 2048; J.dst = W3 + (size_t)j * 4096 * 512 + (size_t)2048 * 512; J.ldd = 512; break;
                    case 5: J.W = args.w_uv + (size_t)j * 512 * 2048; J.K = 512; J.N = 2048; J.dst = W5 + (size_t)j * 2048 * 1024; J.ldd = 1024; J.kind = 3; break;
                    default: J.W = args.w_o + (size_t)j * 2048 * 2048; J.K = 2048; J.N = 2048; J.dst = W6 + (size_t)j * 2048 * 2048; J.ldd = 2048; break;
                } }
            else if (job < 18) { const int j = (job - 14) >> 1;
                if (((job - 14) & 1) == 0) { J.W = args.w_in + (size_t)j * 2048 * 6144; J.K = 2048; J.N = 6144; J.gain = args.norm_mix + (size_t)(2 * j + 1) * DM; J.dst = W9 + (size_t)j * 6144 * 2048; J.ldd = 2048; J.kind = 4; }
                else { J.W = args.w_out + (size_t)j * 2048 * 2048; J.K = 2048; J.N = 2048; J.dst = W10 + (size_t)j * 2048 * 2048; J.ldd = 2048; } }
            else { const int i = (job - 18) >> 1;
                if (((job - 18) & 1) == 0) { J.W = args.w_ff1 + (size_t)i * 2048 * 8192; J.K = 2048; J.N = 8192; J.gain = args.norm_ffn + (size_t)i * DM; J.dst = W7 + (size_t)i * 8192 * 2048; J.ldd = 2048; }
                else { J.W = args.w_ff2 + (size_t)i * 8192 * 2048; J.K = 8192; J.N = 2048; J.dst = W8 + (size_t)i * 2048 * 8192; J.ldd = 8192; } }
            const int nitems = (J.K / 64) * (J.N / 32);
            for (int it = C.gw; it < nitems; it += C.ngw) thin::transpose_item(J, it, scr, lane);
        }
        for (long i = C.gt; i < (long)2 * 512 * 2048 / 8; i += C.ngt) { const f32x4 a = *(const f32x4*)(args.w_uk + i * 8), b = *(const f32x4*)(args.w_uk + i * 8 + 4); *(u32x4*)(WUK + i * 8) = epi::pack8(a, b); }
        for (int j = 0; j < 2; ++j) {
            thin::zero_win(C, W1 + (size_t)j * 1280 * 2048 + (size_t)1088 * 2048, 192, 2048, 2048);
            for (int pn = 0; pn < 8; ++pn) { thin::zero_win(C, W5 + (size_t)j * 2048 * 1024 + (size_t)(pn * 256) * 1024 + 512, 128, 1024, 512);
                                              thin::zero_win(C, W5 + (size_t)j * 2048 * 1024 + (size_t)(pn * 256 + 128) * 1024, 128, 1024, 512); }
            thin::zero_win(C, KC + (size_t)j * DB * KEYP * QLD + 576, DB * KEYP, QLD, 64);
            for (int b = 0; b < DB; ++b) thin::zero_win(C, KC + ((size_t)(j * DB + b) * KEYP + NKEY) * QLD, KEYP - NKEY, QLD, 576);
        }
        thin::zero_win(C, QL + 576, MS * 16, QLD, 64);
        thin::cs_table(C, CS);
        thin::x_to_bf16(C, args.x_prompt, args.x_sample, XB, SSQ);
    }
    PH_END();

    for (int i = 0; i < DEPTH; ++i) {
        const int j = i >> 1;
        if ((i & 1) == 0) {
            if (SITE(1) && PH_ON()) for (int rep_ = 0; rep_ < REPS(1); ++rep_) { SITE_LOCALS;
                pg8::Gemm g{XB, W1 + (size_t)j * 1280 * 2048, 2048, 2048, 32}; pg8::SchedMN S; S.init(MT / 256, 5, G, bx, (size_t)256 * 2048 * 2, (size_t)256 * 2048 * 2);
                epi::EpiW1 E{ssq_mix, CS, CQ, SSQCQ, KVRAW, SSQKV, KR, KCj, out + O_KRP + (size_t)j * MP * 64, out + O_KRS + (size_t)j * MS * 64};
                pg8::gemm_phase(lds, g, S, E);
            }
            PH_END();
            if (SITE(2) && PH_ON()) for (int rep_ = 0; rep_ < REPS(2); ++rep_) { SITE_LOCALS; CTX_LOCALS; thin::ckv_norm(C, KVRAW, SSQKV, args.g_kv + (size_t)j * 512, out + O_CKVP + (size_t)j * MP * 512, out + O_CKVS + (size_t)j * MS * 512, CKV, KCj); }
            if (SITE(3) && PH_ON()) for (int rep_ = 0; rep_ < REPS(3); ++rep_) { SITE_LOCALS;
                pg8::Gemm g{CQ, W2 + (size_t)j * 3072 * 512, 512, 512, 8}; pg8::SchedMN S; S.init(MT / 256, 12, G, bx, (size_t)256 * 512 * 2, (size_t)256 * 512 * 2);
                epi::EpiW2 E{SSQCQ, CS, QN, QR, QL};
                pg8::gemm_phase(lds, g, S, E);
            }
            PH_END();
            if (SITE(4) && PH_ON()) for (int rep_ = 0; rep_ < REPS(4); ++rep_) { SITE_LOCALS;
                { pg8::Gemm g{CKV, W3 + (size_t)j * 4096 * 512, 512, 512, 8}; pg8::SchedMN S; S.init(MP / 256, 16, G, bx, (size_t)256 * 512 * 2, (size_t)256 * 512 * 2);
                  epi::EpiBf16<epi::MapW3> E{epi::MapW3{KN, VV}}; pg8::gemm_phase(lds, g, S, E); }
                { pg8::Gemm g{QN, WUK + (size_t)j * 512 * 2048, 2048, 2048, 2}; SchedQlat S{G, bx};
                  epi::EpiBf16<epi::MapQlat> E{epi::MapQlat{QL}}; pg8::gemm_phase(lds, g, S, E); }
            }
            PH_END();
            if (SITE(5) && PH_ON()) for (int rep_ = 0; rep_ < REPS(5); ++rep_) { SITE_LOCALS;
#ifndef ATT_REP
#define ATT_REP 1
#endif
                for (int ra_ = 0; ra_ < ATT_REP; ++ra_) { const att::Tensors T{QN, QR, KN, KR, VV, OB};
                  const int vcu = (G % 8 == 0) ? (bx % 8) * (G / 8) + bx / 8 : bx;
                  for (int id = vcu; id < 512; id += G) { const int bh = id >> 3, x = id & 7;
                      att::attn_block(T, bh >> 4, bh & 15, 15 - x, (char*)lds_raw); att::attn_block(T, bh >> 4, bh & 15, x, (char*)lds_raw); } }
                { pg8::Gemm g{QL, KCj, QLD, QLD, 10}; SchedScores S{G, bx}; epi::EpiScoresExp E{PP, WSP(float, WS_LP), (unsigned*)(ws + WS_CTL) + CW_SMFLAG + j}; pg8::gemm_phase(lds, g, S, E); }
            }
            PH_END();
            { bool exact_; { SITE_LOCALS; exact_ = use_bar && PH_ON() && __builtin_amdgcn_readfirstlane(__hip_atomic_load((unsigned*)(ws + WS_CTL) + CW_SMFLAG + j, __ATOMIC_RELAXED, __HIP_MEMORY_SCOPE_AGENT)) != 0u; }
              if (exact_) {
                { SITE_LOCALS; pg8::Gemm g{QL, KCj, QLD, QLD, 10}; SchedScores S{G, bx}; epi::EpiBf16<epi::MapScores> E{epi::MapScores{WSP(bf16_t, WS_S)}}; pg8::gemm_phase(lds, g, S, E); }
                xcd_barrier(bar);
                { SITE_LOCALS; CTX_LOCALS; thin::softmax_rows(C, WSP(bf16_t, WS_S), PP); }
                xcd_barrier(bar);
              }
              if (SITE(6) && PH_ON()) { SITE_LOCALS; CTX_LOCALS; thin::rowsum_inv(C, WSP(float, WS_LP), WSP(float, WS_IL), exact_); }
            }
            if (SITE(7) && PH_ON()) for (int rep_ = 0; rep_ < REPS(7); ++rep_) { SITE_LOCALS; pg8::Gemm g{PP, KCj, KEYP, QLD, 66};     SchedPV S{G, bx}; epi::EpiBf16NP<epi::MapPV> E{epi::MapPV{OL}}; pg8::gemm_phase<epi::EpiBf16NP<epi::MapPV>, SchedPV, true>(lds, g, S, E);
                { pg8::Gemm g2{OB, W6 + (size_t)j * 2048 * 2048, 2048, 2048, 32}; SchedEarlyMix S2; S2.init(G, bx); epi::EpiResid E2{XB, ssq_ffn, WSP(float, WS_SLAB)}; pg8::gemm_phase(lds, g2, S2, E2); } }
            PH_END();
            if (SITE(8) && PH_ON()) for (int rep_ = 0; rep_ < REPS(8); ++rep_) { SITE_LOCALS; pg8::Gemm g{OL, W5 + (size_t)j * 2048 * 1024, 8192, 1024, 16}; SchedO2 S{G, bx}; epi::EpiO2 E{OB, WSP(float, WS_IL)}; pg8::gemm_phase(lds, g, S, E); }
            PH_END();
        } else {
            if (SITE(9) && PH_ON()) for (int rep_ = 0; rep_ < REPS(9); ++rep_) { SITE_LOCALS;
                pg8::Gemm g{XB, W9 + (size_t)j * 6144 * 2048, 2048, 2048, 32}; pg8::SchedMN S; S.init(MT / 256, 24, G, bx, (size_t)256 * 2048 * 2, (size_t)256 * 2048 * 2);
                epi::EpiWin E{ssq_mix, GB, UU, out + O_CONVP + (size_t)j * NB * 2 * DM, out + O_CONVS + (size_t)j * DB * 2 * DM};
                pg8::gemm_phase(lds, g, S, E);
            }
            PH_END();
            if (SITE(10) && PH_ON()) for (int rep_ = 0; rep_ < REPS(10); ++rep_) { SITE_LOCALS; CTX_LOCALS; thin::conv_pass(C, GB, UU, args.conv_w + (size_t)j * 3 * DM, args.state_conv + (size_t)j * DB * 2 * DM, OB); }
            PH_END();
        }
        if (SITE(11) && PH_ON()) for (int rep_ = 0; rep_ < REPS(11); ++rep_) { SITE_LOCALS;
            pg8::Gemm g{OB, ((i & 1) == 0 ? W6 : W10) + (size_t)j * 2048 * 2048, 2048, 2048, 32}; SchedResid S; S.init(G, bx, 2048, 2048, 32, false, (i & 1) == 0 ? 256 : 0);
            epi::EpiResid E{XB, ssq_ffn, WSP(float, WS_SLAB)};
            pg8::gemm_phase(lds, g, S, E);
        }
        PH_END();
        if (SITE(15) && PH_ON()) { SITE_LOCALS; CTX_LOCALS; thin::resid_finalize(C, WSP(float, WS_SLAB), XB, ssq_ffn); }
        PH_END();
        if (SITE(12) && PH_ON()) for (int rep_ = 0; rep_ < REPS(12); ++rep_) { SITE_LOCALS;
            pg8::Gemm g{XB, W7 + (size_t)i * 8192 * 2048, 2048, 2048, 32}; pg8::SchedMN S; S.init(MT / 256, 32, G, bx, (size_t)256 * 2048 * 2, (size_t)256 * 2048 * 2, 4);
            epi::EpiFF1 E{ssq_ffn, HB}; pg8::gemm_phase(lds, g, S, E);
        }
        PH_END();
        if (SITE(13) && PH_ON()) for (int rep_ = 0; rep_ < REPS(13); ++rep_) { SITE_LOCALS;
            pg8::Gemm g{HB, W8 + (size_t)i * 2048 * 8192, 8192, 8192, 128}; SchedResid S; S.init(G, bx, 8192, 8192, 128, true);
            epi::EpiResid E{XB, ssq_next, WSP(float, WS_SLAB)}; pg8::gemm_phase(lds, g, S, E);
        }
        PH_END();
        if (SITE(16) && PH_ON()) { SITE_LOCALS; CTX_LOCALS; thin::resid_finalize(C, WSP(float, WS_SLAB), XB, ssq_next); }
        PH_END();
    }
    if (SITE(14) && PH_ON()) for (int rep_ = 0; rep_ < REPS(14); ++rep_) { SITE_LOCALS; CTX_LOCALS; thin::final_norm(C, XB, SSQ + (size_t)8 * MT * 32, args.norm_final, out + O_YP, out + O_YS); }
    PH_END();
#undef PH_ON
#undef PH_END
}

#ifndef MEMSET_BYTES
#define MEMSET_BYTES CTL_BYTES
#endif
extern "C" void kernel_launch(void* const* d_in, const int* in_sizes, int n_in, void* d_out, int out_size, void* d_ws, size_t ws_size, hipStream_t stream) {
    static int grid = 0;
    if (grid == 0) {
        if (n_in != 21 || (size_t)out_size != O_END || ws_size < WS_END) { fprintf(stderr, "kernel_launch: unexpected shapes (n_in %d, out %d, ws %zu; need 21, %zu, >= %zu); nothing launched\n", n_in, out_size, ws_size, (size_t)O_END, (size_t)WS_END); grid = -1; return; }
        int dev = 0, cus = 0, per_cu = 0;
        if (hipGetDevice(&dev) != hipSuccess || hipDeviceGetAttribute(&cus, hipDeviceAttributeMultiprocessorCount, dev) != hipSuccess) { fprintf(stderr, "kernel_launch: device query failed\n"); grid = -1; return; }
        if (hipFuncSetAttribute((const void*)mk_fwd, hipFuncAttributeMaxDynamicSharedMemorySize, LDS_BYTES) != hipSuccess) { fprintf(stderr, "kernel_launch: hipFuncSetAttribute failed\n"); grid = -1; return; }
        if (hipOccupancyMaxActiveBlocksPerMultiprocessor(&per_cu, (const void*)mk_fwd, NWAVES * 64, LDS_BYTES) != hipSuccess || per_cu < 1) { fprintf(stderr, "kernel_launch: occupancy query reports %d workgroups per CU\n", per_cu); per_cu = 1; }
        (void)hipGetLastError();
        grid = cus;
    }
    if (grid < 0) return;
    (void)hipMemsetAsync((char*)d_ws + WS_CTL, 0, (size_t)MEMSET_BYTES, stream);
    Args a{};
    const float** pa = (const float**)&a;
    for (int i = 0; i < 21; ++i) pa[i] = (const float*)d_in[i];
    a.out = (float*)d_out; a.ws = (unsigned char*)d_ws;
#ifndef MK_CHECK
    a.ph_lo = 0; a.ph_hi = N_PHASES;
    hipLaunchKernelGGL(mk_fwd, dim3(grid), dim3(NWAVES * 64), LDS_BYTES, stream, a);
#else
    MK_CHECK_BODY
#endif
}
```

```cpp
#include <hip/hip_runtime.h>
#include <hip/hip_bf16.h>
#include <cstdio>
#include <cstdint>

#define LAS __attribute__((address_space(3)))
#define GAS __attribute__((address_space(1)))
typedef unsigned short bf16_t;
typedef short bf16x8 __attribute__((ext_vector_type(8)));
typedef short s16x4 __attribute__((ext_vector_type(4)));
typedef float f32x2 __attribute__((ext_vector_type(2)));
typedef float f32x4 __attribute__((ext_vector_type(4)));
typedef float f32x16 __attribute__((ext_vector_type(16)));
typedef unsigned u32x2 __attribute__((ext_vector_type(2)));
typedef unsigned u32x4 __attribute__((ext_vector_type(4)));

constexpr int DM = 2048, NB = 4, SEQ = 4096, DEPTH = 4, DB = 32, DS = 32, PAST = 4096;
constexpr int NH = 16, QKN = 128, QKR = 64, VH = 128, QL_ = 512, KVL = 512, DFF = 8192;
constexpr int MP = NB * SEQ;
constexpr int MS = DB * DS;
constexpr int MT = MP + MS;
constexpr int NKEY = PAST + DS;
constexpr int KEYP = 4352;
constexpr int QLD = 640;
constexpr float EPS = 1e-6f;
constexpr float QSCALE = 0.07216878364870322f * 1.4426950408889634f;
constexpr int NPOS = NKEY;

constexpr size_t O_YP = 0;
constexpr size_t O_YS = O_YP + (size_t)MP * DM;
constexpr size_t O_CKVP = O_YS + (size_t)MS * DM;
constexpr size_t O_KRP = O_CKVP + (size_t)2 * MP * KVL;
constexpr size_t O_CONVP = O_KRP + (size_t)2 * MP * QKR;
constexpr size_t O_CKVS = O_CONVP + (size_t)2 * NB * 2 * DM;
constexpr size_t O_KRS = O_CKVS + (size_t)2 * MS * KVL;
constexpr size_t O_CONVS = O_KRS + (size_t)2 * MS * QKR;
constexpr size_t O_END = O_CONVS + (size_t)2 * DB * 2 * DM;
static_assert(O_END == 56000512ull, "d_out size");

constexpr size_t al256(size_t x) { return (x + 255) & ~(size_t)255; }
constexpr size_t WS_CTL = 0, CTL_BYTES = 1u << 20;
constexpr size_t WS_CS = WS_CTL + CTL_BYTES;
constexpr size_t WS_SSQ = al256(WS_CS + (size_t)NPOS * 64 * 4);
constexpr size_t SSQ_ONE = (size_t)MT * 32 * 4;
constexpr size_t WS_SSQCQ = WS_SSQ + 9 * SSQ_ONE;
constexpr size_t WS_SSQKV = WS_SSQCQ + (size_t)MT * 8 * 4;
constexpr size_t WS_X = al256(WS_SSQKV + (size_t)MT * 8 * 4);
constexpr size_t WS_XB = WS_X + (size_t)MT * DM * 4;
constexpr size_t WS_CQ = WS_XB + (size_t)MT * DM * 2;
constexpr size_t WS_KVRAW = WS_CQ + (size_t)MT * 512 * 2;
constexpr size_t WS_CKV = WS_KVRAW + (size_t)MT * 512 * 4;
constexpr size_t WS_KR = WS_CKV + (size_t)MP * 512 * 2;
constexpr size_t WS_QN = WS_KR + (size_t)MP * 64 * 2;
constexpr size_t WS_SLAB = WS_QN;
static_assert((size_t)8 * MS * DM * 4 <= (size_t)MT * 2048 * 2, "slabs fit QN");
constexpr size_t WS_QR = WS_QN + (size_t)MT * 2048 * 2;
constexpr size_t WS_KN = WS_QR + (size_t)MP * 1024 * 2;
constexpr size_t WS_V = WS_KN + (size_t)MT * 2048 * 2;
constexpr size_t WS_GB = WS_KN, WS_U = WS_V;
constexpr size_t WS_O = WS_V + (size_t)MT * 2048 * 2;
constexpr size_t WS_QL = WS_O + (size_t)MT * 2048 * 2;
constexpr size_t WS_OL = WS_QL + (size_t)MS * 16 * QLD * 2;
constexpr size_t WS_KC = WS_OL + (size_t)MS * 16 * 512 * 2;
constexpr size_t KC_ONE = (size_t)DB * KEYP * QLD * 2;
constexpr size_t WS_VT = WS_KC + 2 * KC_ONE;
constexpr size_t WS_LP = WS_VT;
constexpr int LPP = 72;
constexpr size_t WS_IL = WS_LP + (size_t)DB * 512 * LPP * 4;
constexpr size_t VT_ONE = (size_t)DB * 512 * KEYP * 2;
constexpr size_t WS_S = WS_VT + 2 * VT_ONE;
constexpr size_t WS_HB = WS_S;
constexpr size_t S_BYTES = (size_t)DB * 512 * KEYP * 4;
static_assert(S_BYTES >= (size_t)MT * DFF * 2, "HB overlays S");
constexpr size_t WS_P = WS_S + S_BYTES;
constexpr size_t WS_W1 = WS_P + (size_t)DB * 512 * KEYP * 2;
constexpr size_t WS_W2 = WS_W1 + (size_t)2 * 1280 * 2048 * 2;
constexpr size_t WS_W3 = WS_W2 + (size_t)2 * 3072 * 512 * 2;
constexpr size_t WS_WUK = WS_W3 + (size_t)2 * 4096 * 512 * 2;
constexpr size_t WS_W5 = WS_WUK + (size_t)2 * 512 * 2048 * 2;
constexpr size_t WS_W6 = WS_W5 + (size_t)2 * 8 * 256 * 1024 * 2;
constexpr size_t WS_W10 = WS_W6 + (size_t)2 * 2048 * 2048 * 2;
constexpr size_t WS_W9 = WS_W10 + (size_t)2 * 2048 * 2048 * 2;
constexpr size_t WS_W7 = WS_W9 + (size_t)2 * 6144 * 2048 * 2;
constexpr size_t WS_W8 = WS_W7 + (size_t)4 * 8192 * 2048 * 2;
constexpr size_t WS_END = WS_W8 + (size_t)4 * 2048 * 8192 * 2;
static_assert(WS_END <= 2147483648ull, "workspace map must fit 4 x largest tensor");

constexpr int CW_BAR = 4096, CW_SMFLAG = 12288;

__device__ __forceinline__ unsigned cvt_pk_bf16(float lo, float hi) { unsigned r; asm volatile("v_cvt_pk_bf16_f32 %0, %1, %2" : "=v"(r) : "v"(lo), "v"(hi)); return r; }
__device__ __forceinline__ float bf2f(unsigned short b) { return __uint_as_float((unsigned)b << 16); }
__device__ __forceinline__ float wave_sum(float v) {
#pragma unroll
    for (int o = 1; o < 64; o <<= 1) v += __shfl_xor(v, o);
    return v;
}
__device__ __forceinline__ float wave_max(float v) {
#pragma unroll
    for (int o = 1; o < 64; o <<= 1) v = fmaxf(v, __shfl_xor(v, o));
    return v;
}
#define LDS_WAIT() asm volatile("s_waitcnt lgkmcnt(0)" ::: "memory")
#define VM_WAIT() asm volatile("s_waitcnt vmcnt(0)" ::: "memory")

namespace pg8 {
constexpr int BM = 256, BK = 64, HALF = 128, HTB = HALF * BK * 2, STAGE_BYTES = 8 * HTB, NXCD = 8, WGM = 8;
__host__ __device__ __forceinline__ int lds_byte(int r, int c) { const int st = (r >> 4) * 2 + (c >> 5), rr = r & 15, cc = c & 31, ob = rr * 64 + cc * 2; return st * 1024 + (ob ^ (((ob >> 9) & 1) << 5)); }
__host__ __device__ __forceinline__ void stage_rc(int b, int& R, int& C) { const int st = b / 1024, sb = b % 1024, swz = sb ^ (((sb >> 9) & 1) << 5); R = (st >> 1) * 16 + swz / 64; C = (st & 1) * 32 + (swz % 64) / 2; }
__host__ __device__ __forceinline__ int perm32(int rho) { const int n = rho >> 4, i = rho & 15; return 8 * (i >> 2) + 4 * n + (i & 3); }

struct Unit { int pm, pn, z; };
struct Gemm { const bf16_t* A; const bf16_t* Bt; int lda, ldb, nt; };

struct SchedMN {
    int nM, nN, nwg, G, c, wgm; size_t astep, bstep;
    __device__ __forceinline__ void init(int nM_, int nN_, int G_, int c_, size_t astep_, size_t bstep_, int wgm_ = WGM) { nM = nM_; nN = nN_; nwg = nM * nN; G = G_; c = c_; astep = astep_; bstep = bstep_; wgm = wgm_; }
    __device__ __forceinline__ bool next(int i, Unit& u, size_t& aoff, size_t& boff, int& unt) const { return map((long)i * G + c, u, aoff, boff); }
    __device__ __forceinline__ bool map(const long L, Unit& u, size_t& aoff, size_t& boff) const {
        if (L >= nwg) return false;
        int wgid = (int)L; { const int q = nwg / NXCD, r = nwg % NXCD, xcd = wgid % NXCD, off = wgid / NXCD; wgid = (xcd < r ? xcd * (q + 1) : r * (q + 1) + (xcd - r) * q) + off; }
        const int nig = wgm * nN, gid = wgid / nig, fm = gid * wgm, gsz = (nM - fm) < wgm ? (nM - fm) : wgm;
        u.pm = fm + ((wgid % nig) % gsz); u.pn = (wgid % nig) / gsz; u.z = 0;
        aoff = (size_t)u.pm * astep; boff = (size_t)u.pn * bstep; return true;
    }
};

template <class Epi, class Sched, bool BTR = false>
__device__ __forceinline__ void gemm_phase(LAS unsigned char* lds, const Gemm g, const Sched& S, const Epi& E) {
    int tid = threadIdx.x; asm volatile("" : "+v"(tid));
    const int wid = __builtin_amdgcn_readfirstlane(tid >> 6), lane = tid & 63, wr = wid >> 2, wc = wid & 3, fr = lane & 15, fq = lane >> 4;
    int nt = g.nt; asm volatile("" : "+s"(nt));
    int nnt = nt;
    unsigned voffA[2], voffB[2];
#pragma unroll
    for (int i = 0; i < 2; ++i) { int R, C; stage_rc(tid * 16 + i * 8192, R, C); const int Rb = Epi::PERM ? ((R & ~31) + perm32(R & 31)) : R;
        voffA[i] = (unsigned)(R * g.lda + C) * 2u; voffB[i] = (unsigned)(Rb * g.ldb + C) * 2u;
        if constexpr (BTR) { const unsigned sb = (unsigned)(tid * 16 + i * 8192), row = sb >> 8, ch = ((sb >> 4) & 15u) ^ (((row & 3u) << 2) | ((row >> 2) & 3u));
            voffB[i] = (row * (unsigned)g.ldb + ch * 8u) * 2u; } }
    const size_t hstepA = (size_t)HALF * g.lda * 2, hstepB = BTR ? (size_t)HALF * 2 : (size_t)HALF * g.ldb * 2;
    const long kmulB = BTR ? (long)g.ldb : 1L;
    unsigned trb[2][2];
    if constexpr (BTR) {
#pragma unroll
        for (int n = 0; n < 2; ++n)
#pragma unroll
            for (int t = 0; t < 2; ++t) { const unsigned q = (unsigned)(lane & 15) >> 2, p = (unsigned)lane & 3u, row = 8u * (unsigned)fq + 4u * t + q, ch = 2u * (unsigned)(wc * 2 + n) + (p >> 1);
                trb[n][t] = (unsigned)(size_t)lds + 4u * HTB + 256u * row + 16u * (ch ^ (((row & 3u) << 2) | ((row >> 2) & 3u))) + 8u * (p & 1u); } }
    const unsigned ldsw = (unsigned)wid * 1024u;
    const int aoff = lds_byte(wr * 64 + fr, fq * 8), boff = lds_byte(wc * 32 + fr, fq * 8);
#define PG8_SA(b, h) (((b) * 2 + (h)) * HTB)
#define PG8_SB(b, h) ((4 + (b) * 2 + (h)) * HTB)
#define PG8_STAGE(bufoff, gbase, voff) do { _Pragma("unroll") for (int _i = 0; _i < 2; ++_i) \
        __builtin_amdgcn_global_load_lds((const unsigned*)((const char*)(gbase) + (voff)[_i]), (LAS unsigned*)(lds + (bufoff) + ldsw + _i * 8192), 16, 0, 0); } while (0)
#define PG8_LDA(dst, b, h) do { _Pragma("unroll") for (int m = 0; m < 4; ++m) _Pragma("unroll") for (int k = 0; k < 2; ++k) dst[m][k] = *(const LAS bf16x8*)(lds + PG8_SA(b, h) + aoff + m * 2048 + k * 1024); } while (0)
#define PG8_LDB(dst, b, h) do { _Pragma("unroll") for (int n = 0; n < 2; ++n) _Pragma("unroll") for (int k = 0; k < 2; ++k) dst[n][k] = *(const LAS bf16x8*)(lds + PG8_SB(b, h) + boff + n * 2048 + k * 1024); } while (0)
#define PG8_TR(dst, addr, off) asm volatile("ds_read_b64_tr_b16 %0, %1 offset:%2" : "=v"(dst) : "v"(addr), "i"(off) : "memory")
#define PG8_LDBT(T, b, h) do { _Pragma("unroll") for (int n = 0; n < 2; ++n) _Pragma("unroll") for (int k = 0; k < 2; ++k) { \
        PG8_TR(T[n][k][0], trb[n][0], ((b) * 2 + (h)) * HTB + k * 8192); PG8_TR(T[n][k][1], trb[n][1], ((b) * 2 + (h)) * HTB + k * 8192); } } while (0)
#define PG8_TIE8(T) "+v"(T[0][0][0]), "+v"(T[0][0][1]), "+v"(T[0][1][0]), "+v"(T[0][1][1]), "+v"(T[1][0][0]), "+v"(T[1][0][1]), "+v"(T[1][1][0]), "+v"(T[1][1][1])
#define PG8_MKB(B, T) do { _Pragma("unroll") for (int n = 0; n < 2; ++n) _Pragma("unroll") for (int k = 0; k < 2; ++k) \
        B[n][k] = (bf16x8){T[n][k][0][0], T[n][k][0][1], T[n][k][0][2], T[n][k][0][3], T[n][k][1][0], T[n][k][1][1], T[n][k][1][2], T[n][k][1][3]}; } while (0)
#define PG8_MMA(ai, bj, At, Bt) do { __builtin_amdgcn_s_setprio(1); _Pragma("unroll") for (int m = 0; m < 4; ++m) _Pragma("unroll") for (int n = 0; n < 2; ++n) _Pragma("unroll") for (int k = 0; k < 2; ++k) \
        acc[ai][bj][m][n] = __builtin_amdgcn_mfma_f32_16x16x32_bf16(Bt[n][k], At[m][k], acc[ai][bj][m][n], 0, 0, 0); __builtin_amdgcn_s_setprio(0); } while (0)
#define PG8_WAIT_V(n) asm volatile("s_waitcnt vmcnt(" #n ")" ::: "memory")
#define PG8_WAIT_L(n) asm volatile("s_waitcnt lgkmcnt(" #n ")" ::: "memory")
#define PG8_BAR __builtin_amdgcn_s_barrier()
#define PG8_SCHED __builtin_amdgcn_sched_barrier(0)
    Unit cur, nxt; int ui = 0; size_t uao, ubo;
    if (!S.next(0, cur, uao, ubo, nt)) return;
    long kstep = nt < 0 ? -(long)(BK * 2) : (long)(BK * 2), nkstep = (long)(BK * 2); if (nt < 0) nt = -nt;
    f32x4 acc[2][2][4][2];
#pragma unroll
    for (int a = 0; a < 2; ++a)
#pragma unroll
        for (int b = 0; b < 2; ++b)
#pragma unroll
            for (int m = 0; m < 4; ++m)
#pragma unroll
                for (int n = 0; n < 2; ++n) acc[a][b][m][n] = (f32x4){0.f, 0.f, 0.f, 0.f};
    bf16x8 At[4][2], B0[2][2], B1[2][2]; s16x4 T0[2][2][2], T1[2][2][2];
    const char* cA = (const char*)g.A + uao; const char* cB = (const char*)g.Bt + ubo;
    PG8_STAGE(PG8_SB(0, 0), cB, voffB); PG8_STAGE(PG8_SB(0, 1), cB + hstepB, voffB); PG8_STAGE(PG8_SA(0, 0), cA, voffA); PG8_STAGE(PG8_SA(0, 1), cA + hstepA, voffA);
    if (wr == 1) PG8_BAR;
    PG8_WAIT_V(2); PG8_BAR;
    PG8_STAGE(PG8_SB(1, 0), cB + kstep * kmulB, voffB); PG8_STAGE(PG8_SA(1, 0), cA + kstep, voffA); PG8_STAGE(PG8_SB(1, 1), cB + hstepB + kstep * kmulB, voffB);
    PG8_WAIT_V(6); PG8_BAR;
    for (;;) {
        const bool has_next = S.next(ui + 1, nxt, uao, ubo, nnt);
        if (has_next) { nkstep = nnt < 0 ? -(long)(BK * 2) : (long)(BK * 2); if (nnt < 0) nnt = -nnt; } else nkstep = kstep;
        const char* nA = has_next ? (const char*)g.A + uao : cA; const char* nB = has_next ? (const char*)g.Bt + ubo : cB;
        for (int t = 0; t < nt; t += 2) {
            const bool last = (t == nt - 2);
            const char* a1 = cA + (long)(t + 1) * kstep;
            const char* a2 = last ? nA : cA + (long)(t + 2) * kstep; const char* b2 = last ? nB : cB + (long)(t + 2) * kstep * kmulB;
            const long ks3 = last ? nkstep : kstep; const char* a3 = a2 + ks3; const char* b3 = b2 + ks3 * kmulB;
            if constexpr (BTR) { PG8_LDBT(T0, 0, 0); PG8_LDBT(T1, 0, 1); } else { PG8_LDB(B0, 0, 0); PG8_LDB(B1, 0, 1); }
            PG8_SCHED; PG8_LDA(At, 0, 0); PG8_STAGE(PG8_SA(1, 1), a1 + hstepA, voffA);
            PG8_WAIT_V(8);
            if constexpr (BTR) { asm volatile("s_waitcnt lgkmcnt(0)" : PG8_TIE8(T0), PG8_TIE8(T1) :: "memory"); PG8_SCHED; PG8_MKB(B0, T0); PG8_MKB(B1, T1); } else PG8_WAIT_L(0);
            PG8_BAR; PG8_MMA(0, 0, At, B0); PG8_MMA(0, 1, At, B1); PG8_BAR; PG8_SCHED;
            PG8_LDA(At, 0, 1); PG8_STAGE(PG8_SB(0, 0), b2, voffB); PG8_STAGE(PG8_SB(0, 1), b2 + hstepB, voffB); PG8_STAGE(PG8_SA(0, 0), a2, voffA);
            PG8_WAIT_V(8); PG8_WAIT_L(0); PG8_BAR; PG8_MMA(1, 0, At, B0); PG8_MMA(1, 1, At, B1); PG8_BAR; PG8_SCHED;
            if constexpr (BTR) { PG8_LDBT(T0, 1, 0); PG8_LDBT(T1, 1, 1); } else { PG8_LDB(B0, 1, 0); PG8_LDB(B1, 1, 1); }
            PG8_SCHED; PG8_LDA(At, 1, 0); PG8_STAGE(PG8_SA(0, 1), a2 + hstepA, voffA);
            PG8_WAIT_V(8);
            if constexpr (BTR) { asm volatile("s_waitcnt lgkmcnt(0)" : PG8_TIE8(T0), PG8_TIE8(T1) :: "memory"); PG8_SCHED; PG8_MKB(B0, T0); PG8_MKB(B1, T1); } else PG8_WAIT_L(0);
            PG8_BAR; PG8_MMA(0, 0, At, B0); PG8_MMA(0, 1, At, B1); PG8_BAR; PG8_SCHED;
            PG8_LDA(At, 1, 1); PG8_STAGE(PG8_SB(1, 0), b3, voffB); PG8_STAGE(PG8_SB(1, 1), b3 + hstepB, voffB); PG8_STAGE(PG8_SA(1, 0), a3, voffA);
            PG8_WAIT_V(8); PG8_WAIT_L(0); PG8_BAR; PG8_MMA(1, 0, At, B0); PG8_MMA(1, 1, At, B1); PG8_BAR; PG8_SCHED;
        }
        if (wr == 0) PG8_BAR;
        E(acc, cur, wr, wc, fr, fq);
        if (!has_next) break;
#pragma unroll
        for (int a = 0; a < 2; ++a)
#pragma unroll
            for (int b = 0; b < 2; ++b)
#pragma unroll
                for (int m = 0; m < 4; ++m)
#pragma unroll
                    for (int n = 0; n < 2; ++n) acc[a][b][m][n] = (f32x4){0.f, 0.f, 0.f, 0.f};
        cur = nxt; cA = nA; cB = nB; ++ui; nt = nnt; kstep = nkstep;
        if (wr == 1) PG8_BAR;
    }
    PG8_WAIT_V(0);
    PG8_BAR;
#undef PG8_SA
#undef PG8_SB
#undef PG8_STAGE
#undef PG8_LDA
#undef PG8_LDB
#undef PG8_TR
#undef PG8_LDBT
#undef PG8_TIE8
#undef PG8_MKB
#undef PG8_MMA
#undef PG8_WAIT_V
#undef PG8_WAIT_L
#undef PG8_BAR
#undef PG8_SCHED
}
}

namespace epi {
using pg8::Unit; using pg8::BM; using pg8::HALF;
typedef f32x4 Acc[2][2][4][2];

template <int NP> __device__ __forceinline__ float row_rstd(const float* part, int row, int fq, float inv_n) {
    float s;
    if constexpr (NP == 32) { const f32x4 a = *(const f32x4*)(part + (size_t)row * 32 + fq * 8), b = *(const f32x4*)(part + (size_t)row * 32 + fq * 8 + 4);
        s = ((a[0] + a[1]) + (a[2] + a[3])) + ((b[0] + b[1]) + (b[2] + b[3])); }
    else { const f32x2 a = *(const f32x2*)(part + (size_t)row * 8 + fq * 2); s = a[0] + a[1]; }
    s += __shfl_xor(s, 16); s += __shfl_xor(s, 32);
    return 1.0f / sqrtf(s * inv_n + EPS);
}
__device__ __forceinline__ float sq4(const f32x4 v) { return (v[0] * v[0] + v[1] * v[1]) + (v[2] * v[2] + v[3] * v[3]); }
__device__ __forceinline__ float sq0(const f32x4 a) { return (a[0] + a[1]) + (a[2] + a[3]); }
__device__ __forceinline__ u32x4 pack8(const f32x4 a, const f32x4 b) { u32x4 w; w.x = cvt_pk_bf16(a[0], a[1]); w.y = cvt_pk_bf16(a[2], a[3]); w.z = cvt_pk_bf16(b[0], b[1]); w.w = cvt_pk_bf16(b[2], b[3]); return w; }
__device__ __forceinline__ f32x4 rope4(const f32x4 v, const f32x4 cs) { return (f32x4){v[0] * cs[0] - v[1] * cs[1], v[0] * cs[1] + v[1] * cs[0], v[2] * cs[2] - v[3] * cs[3], v[2] * cs[3] + v[3] * cs[2]}; }
__device__ __forceinline__ int row_pos(int row) { return row < MP ? (row & (SEQ - 1)) : PAST + ((row - MP) & (DS - 1)); }

struct EpiResid {
    static constexpr bool PERM = true;
    bf16_t* XB; float* ssq; float* slab;
    __device__ __forceinline__ void operator()(const Acc& acc, const Unit& u, int wr, int wc, int fr, int fq) const {
        const int row0 = u.pm * BM + wr * 64 + fr, col0 = u.pn * BM + wc * 32 + 8 * fq;
        if (u.z == 0) {
#pragma unroll
        for (int ai = 0; ai < 2; ++ai)
#pragma unroll
            for (int m = 0; m < 4; ++m) { const int row = row0 + ai * HALF + m * 16;
                bf16_t* xr = XB + (size_t)row * DM + col0;
                float s = 0.f;
#pragma unroll
                for (int bj = 0; bj < 2; ++bj) { const u32x4 xo = *(const u32x4*)(xr + bj * HALF);
                    f32x4 v0 = acc[ai][bj][m][0], v1 = acc[ai][bj][m][1];
                    v0[0] += __uint_as_float(xo.x << 16); v0[1] += __uint_as_float(xo.x & 0xffff0000u); v0[2] += __uint_as_float(xo.y << 16); v0[3] += __uint_as_float(xo.y & 0xffff0000u);
                    v1[0] += __uint_as_float(xo.z << 16); v1[1] += __uint_as_float(xo.z & 0xffff0000u); v1[2] += __uint_as_float(xo.w << 16); v1[3] += __uint_as_float(xo.w & 0xffff0000u);
                    *(u32x4*)(xr + bj * HALF) = pack8(v0, v1); s += sq4(v0) + sq4(v1); }
                s += __shfl_xor(s, 16); s += __shfl_xor(s, 32);
                if (fq == 0) ssq[(size_t)row * 32 + u.pn * 4 + wc] = s; }
        } else {
            bf16_t* sl = (bf16_t*)slab + (size_t)(u.z - 1) * MS * DM;
#pragma unroll
        for (int ai = 0; ai < 2; ++ai)
#pragma unroll
            for (int m = 0; m < 4; ++m) { bf16_t* p = sl + (size_t)(row0 - MP + ai * HALF + m * 16) * DM + col0;
#pragma unroll
                for (int bj = 0; bj < 2; ++bj) *(u32x4*)(p + bj * HALF) = pack8(acc[ai][bj][m][0], acc[ai][bj][m][1]); }
        }
    }
};
struct EpiFF1 {
    static constexpr bool PERM = true;
    const float* ssq; bf16_t* HB;
    __device__ __forceinline__ void operator()(const Acc& acc, const Unit& u, int wr, int wc, int fr, int fq) const {
        const int row0 = u.pm * BM + wr * 64 + fr, col0 = u.pn * BM + wc * 32 + 8 * fq;
#pragma unroll
        for (int ai = 0; ai < 2; ++ai)
#pragma unroll
            for (int m = 0; m < 4; ++m) { const int row = row0 + ai * HALF + m * 16; const float r = row_rstd<32>(ssq, row, fq, 1.0f / DM);
#pragma unroll
                for (int bj = 0; bj < 2; ++bj) { f32x4 v0 = acc[ai][bj][m][0] * r, v1 = acc[ai][bj][m][1] * r;
#pragma unroll
                    for (int e = 0; e < 4; ++e) { const float a = fmaxf(v0[e], 0.f), b = fmaxf(v1[e], 0.f); v0[e] = a * a; v1[e] = b * b; }
                    *(u32x4*)(HB + (size_t)row * DFF + col0 + bj * HALF) = pack8(v0, v1); } }
    }
};
struct EpiW1 {
    static constexpr bool PERM = true;
    const float* ssq; const float* cs; bf16_t* CQ; float* ssqcq; float* KVRAW; float* ssqkv; bf16_t* KR; bf16_t* KC  ; float* okrp; float* okrs  ;
    __device__ __forceinline__ void operator()(const Acc& acc, const Unit& u, int wr, int wc, int fr, int fq) const {
        const int row0 = u.pm * BM + wr * 64 + fr; const int pn = u.pn;
        if (pn == 4 && wc >= 2) return;
#pragma unroll
        for (int ai = 0; ai < 2; ++ai)
#pragma unroll
            for (int m = 0; m < 4; ++m) { const int row = row0 + ai * HALF + m * 16; const float r = row_rstd<32>(ssq, row, fq, 1.0f / DM);
                if (pn < 4) { float s = 0.f; const int cl = (pn & 1) * BM + wc * 32 + 8 * fq;
#pragma unroll
                    for (int bj = 0; bj < 2; ++bj) { const f32x4 v0 = acc[ai][bj][m][0] * r, v1 = acc[ai][bj][m][1] * r; s += sq4(v0) + sq4(v1);
                        if (pn < 2) *(u32x4*)(CQ + (size_t)row * 512 + cl + bj * HALF) = pack8(v0, v1);
                        else *(u32x4*)((bf16_t*)KVRAW + (size_t)row * 512 + cl + bj * HALF) = pack8(v0, v1); }
                    s += __shfl_xor(s, 16); s += __shfl_xor(s, 32);
                    if (fq == 0) { if (pn < 2) ssqcq[(size_t)row * 8 + pn * 4 + wc] = s; else ssqkv[(size_t)row * 8 + (pn - 2) * 4 + wc] = s; } }
                else {
                    const int pos = row_pos(row), p0 = 16 * wc + 4 * fq;
                    const f32x4 c0 = *(const f32x4*)(cs + (size_t)pos * 64 + p0 * 2), c1 = *(const f32x4*)(cs + (size_t)pos * 64 + p0 * 2 + 4);
                    const f32x4 o0 = rope4(acc[ai][0][m][0] * r, c0), o1 = rope4(acc[ai][0][m][1] * r, c1);
                    const u32x4 w = pack8(o0, o1); float* of;
                    if (row < MP) { *(u32x4*)(KR + (size_t)row * 64 + 2 * p0) = w; of = okrp + (size_t)row * 64; }
                    else { const int tok = row - MP, b = tok >> 5, t = tok & 31; *(u32x4*)(KC + ((size_t)b * KEYP + PAST + t) * QLD + 512 + 2 * p0) = w; of = okrs + (size_t)tok * 64; }
                    of[p0] = o0[0]; of[p0 + 32] = o0[1]; of[p0 + 1] = o0[2]; of[p0 + 33] = o0[3];
                    of[p0 + 2] = o1[0]; of[p0 + 34] = o1[1]; of[p0 + 3] = o1[2]; of[p0 + 35] = o1[3]; } }
    }
};
struct EpiW2 {
    static constexpr bool PERM = true;
    const float* ssqcq; const float* cs; bf16_t* QN; bf16_t* QR; bf16_t* QL;
    __device__ __forceinline__ void operator()(const Acc& acc, const Unit& u, int wr, int wc, int fr, int fq) const {
        const int row0 = u.pm * BM + wr * 64 + fr; const int pn = u.pn;
#pragma unroll
        for (int ai = 0; ai < 2; ++ai)
#pragma unroll
            for (int m = 0; m < 4; ++m) { const int row = row0 + ai * HALF + m * 16; const float r = row_rstd<8>(ssqcq, row, fq, 1.0f / 512.0f) * QSCALE;
                if (pn < 8) {
#pragma unroll
                    for (int bj = 0; bj < 2; ++bj) *(u32x4*)(QN + (size_t)row * 2048 + pn * BM + bj * HALF + wc * 32 + 8 * fq) = pack8(acc[ai][bj][m][0] * r, acc[ai][bj][m][1] * r); }
                else { const int pos = row_pos(row), p0 = 16 * (wc & 1) + 4 * fq;
                    const f32x4 c0 = *(const f32x4*)(cs + (size_t)pos * 64 + p0 * 2), c1 = *(const f32x4*)(cs + (size_t)pos * 64 + p0 * 2 + 4);
#pragma unroll
                    for (int bj = 0; bj < 2; ++bj) { const int g = (pn - 8) * BM + bj * HALF + wc * 32;
                        const u32x4 w = pack8(rope4(acc[ai][bj][m][0] * r, c0), rope4(acc[ai][bj][m][1] * r, c1));
                        if (row < MP) *(u32x4*)(QR + (size_t)row * 1024 + g + 8 * fq) = w;
                        else *(u32x4*)(QL + ((size_t)(row - MP) * 16 + (g >> 6)) * QLD + 512 + (g & 63) + 8 * fq) = w; } } }
    }
};
template <class Map> struct EpiBf16 {
    static constexpr bool PERM = true;
    Map map;
    __device__ __forceinline__ void operator()(const Acc& acc, const Unit& u, int wr, int wc, int fr, int fq) const {
#pragma unroll
        for (int ai = 0; ai < 2; ++ai)
#pragma unroll
            for (int m = 0; m < 4; ++m) { bf16_t* p = map(u, ai * HALF + wr * 64 + m * 16 + fr) + wc * 32 + 8 * fq;
#pragma unroll
                for (int bj = 0; bj < 2; ++bj) *(u32x4*)(p + bj * HALF) = pack8(acc[ai][bj][m][0], acc[ai][bj][m][1]); }
    }
};
template <class Map> struct EpiBf16NP {
    static constexpr bool PERM = false;
    Map map;
    __device__ __forceinline__ void operator()(const Acc& acc, const Unit& u, int wr, int wc, int fr, int fq) const {
#pragma unroll
        for (int ai = 0; ai < 2; ++ai)
#pragma unroll
            for (int m = 0; m < 4; ++m) { bf16_t* p = map(u, ai * HALF + wr * 64 + m * 16 + fr) + wc * 32 + 4 * fq;
#pragma unroll
                for (int bj = 0; bj < 2; ++bj)
#pragma unroll
                    for (int n = 0; n < 2; ++n) { const f32x4 v = acc[ai][bj][m][n]; u32x2 w; w.x = cvt_pk_bf16(v[0], v[1]); w.y = cvt_pk_bf16(v[2], v[3]); *(u32x2*)(p + bj * HALF + 16 * n) = w; } }
    }
};
struct MapW3 { bf16_t* KN; bf16_t* V; __device__ __forceinline__ bf16_t* operator()(const Unit& u, int r) const { return (u.pn < 8 ? KN + u.pn * BM : V + (u.pn - 8) * BM) + (size_t)(u.pm * BM + r) * 2048; } };
struct MapQlat { bf16_t* QL; __device__ __forceinline__ bf16_t* operator()(const Unit& u, int r) const { return QL + ((size_t)(u.pm * BM + r) * 16 + u.z) * QLD + u.pn * BM; } };
struct MapPV { bf16_t* OL; __device__ __forceinline__ bf16_t* operator()(const Unit& u, int r) const { return OL + ((size_t)u.z * 512 + u.pm * BM + r) * 512 + u.pn * BM; } };
struct MapO2 { bf16_t* O; __device__ __forceinline__ bf16_t* operator()(const Unit& u, int r) const { return O + (size_t)(MP + u.pm * BM + r) * 2048 + u.pn * BM; } };
struct MapScores { bf16_t* S; __device__ __forceinline__ bf16_t* operator()(const Unit& u, int r) const { return S + ((size_t)u.z * 512 + u.pm * BM + r) * KEYP + u.pn * BM; } };
constexpr float SM_LIM = 96.0f;
struct EpiScoresExp {
    static constexpr bool PERM = true;
    bf16_t* P; float* LP; unsigned* flag;
    __device__ __forceinline__ void operator()(const Acc& acc, const Unit& u, int wr, int wc, int fr, int fq) const {
        const bool tail = (u.pn == 16);
        float amax = 0.f;
#pragma unroll
        for (int ai = 0; ai < 2; ++ai)
#pragma unroll
            for (int m = 0; m < 4; ++m) { const int r = ai * HALF + wr * 64 + m * 16 + fr; const size_t R = (size_t)u.z * 512 + u.pm * BM + r;
                bf16_t* p = P + R * KEYP + u.pn * BM + wc * 32 + 8 * fq; float s = 0.f;
#pragma unroll
                for (int bj = 0; bj < 2; ++bj) { f32x4 v0 = acc[ai][bj][m][0], v1 = acc[ai][bj][m][1];
                    const bool dead = tail && (bj == 1 || wc != 0);
#pragma unroll
                    for (int e = 0; e < 4; ++e) { amax = fmaxf(amax, fmaxf(fabsf(v0[e]), fabsf(v1[e]))); v0[e] = dead ? 0.f : __builtin_amdgcn_exp2f(v0[e]); v1[e] = dead ? 0.f : __builtin_amdgcn_exp2f(v1[e]); }
                    s += sq0(v0) + sq0(v1); *(u32x4*)(p + bj * HALF) = pack8(v0, v1); }
                s += __shfl_xor(s, 16); s += __shfl_xor(s, 32);
                if (fq == 0) LP[R * LPP + u.pn * 4 + wc] = s; }
        if (__any(!(amax <= SM_LIM))) { if (fr == 0 && fq == 0) __hip_atomic_store(flag, 1u, __ATOMIC_RELAXED, __HIP_MEMORY_SCOPE_AGENT); }
    }
};
struct EpiO2 {
    static constexpr bool PERM = true;
    bf16_t* O; const float* IL;
    __device__ __forceinline__ void operator()(const Acc& acc, const Unit& u, int wr, int wc, int fr, int fq) const {
#pragma unroll
        for (int ai = 0; ai < 2; ++ai)
#pragma unroll
            for (int m = 0; m < 4; ++m) { const int tok = u.pm * BM + ai * HALF + wr * 64 + m * 16 + fr; bf16_t* p = O + (size_t)(MP + tok) * 2048 + u.pn * BM + wc * 32 + 8 * fq;
#pragma unroll
                for (int bj = 0; bj < 2; ++bj) { const float il = IL[(size_t)tok * 16 + u.pn * 2 + bj]; *(u32x4*)(p + bj * HALF) = pack8(acc[ai][bj][m][0] * il, acc[ai][bj][m][1] * il); } }
    }
};
struct EpiWin {
    static constexpr bool PERM = true;
    const float* ssq; bf16_t* GB; bf16_t* U; float* ocp; float* ocs  ;
    __device__ __forceinline__ void operator()(const Acc& acc, const Unit& u, int wr, int wc, int fr, int fq) const {
        const int row0 = u.pm * BM + wr * 64 + fr; const int pn = u.pn;
#pragma unroll
        for (int ai = 0; ai < 2; ++ai)
#pragma unroll
            for (int m = 0; m < 4; ++m) { const int row = row0 + ai * HALF + m * 16; const float r = row_rstd<32>(ssq, row, fq, 1.0f / DM);
                if (pn < 8) {
#pragma unroll
                    for (int bj = 0; bj < 2; ++bj) *(u32x4*)(GB + (size_t)row * DM + pn * BM + bj * HALF + wc * 32 + 8 * fq) = pack8(acc[ai][bj][m][0] * r, acc[ai][bj][m][1] * r); }
                else { const float r2 = r * r; const int c = (pn - 8) * HALF + wc * 32 + 8 * fq;
                    const f32x4 u0 = acc[ai][0][m][0] * acc[ai][1][m][0] * r2, u1 = acc[ai][0][m][1] * acc[ai][1][m][1] * r2;
                    *(u32x4*)(U + (size_t)row * DM + c) = pack8(u0, u1);
                    float* of = nullptr;
                    if (row < MP) { const int t = row & (SEQ - 1); if (t >= SEQ - 2) of = ocp + ((size_t)(row >> 12) * 2 + (t - (SEQ - 2))) * DM; }
                    else { const int tok = row - MP, t = tok & 31; if (t >= DS - 2) of = ocs + ((size_t)(tok >> 5) * 2 + (t - (DS - 2))) * DM; }
                    if (of) { *(f32x4*)(of + c) = u0; *(f32x4*)(of + c + 4) = u1; } } }
    }
};
}

namespace att {
constexpr int NW = 8, QBLK = 32, KVBLK = 64, QB = NW * QBLK, D = 128;
constexpr int SHM_V = KVBLK * D * 2, SHM_K = KVBLK * D * 2, SHM_R = KVBLK * 64 * 2;
constexpr int OFF_V = 0, OFF_K = 2 * SHM_V, OFF_R = OFF_K + 2 * SHM_K, OFF_WS = OFF_R + 2 * SHM_R, OFF_QR = OFF_WS + NW * 64 * 4, LDS_BYTES = OFF_QR + NW * 4096;
constexpr float THR2 = 11.0f;
#define KSWZ(row, colB) ((row) * 256 + ((colB) ^ (((row) & 7) << 4)))
#define RSWZ(row, colB) ((row) * 128 + ((colB) ^ (((row) & 7) << 4)))
#define SBAR() __builtin_amdgcn_sched_barrier(0)
__device__ __forceinline__ int v_st(int k, int c) { const int kk = (k & ~0xC) | ((k & 4) << 1) | ((k & 8) >> 1); return ((kk >> 3) * 4 + (c >> 5)) * 512 + ((kk & 7) * 32 + (c & 31)) * 2; }
__device__ __forceinline__ int v_rd_base(int lane) { return ((lane & 3) << 3) | (((lane >> 2) & 3) << 6) | (((lane >> 4) & 1) << 5) | (((lane >> 5) & 1) << 8); }
constexpr int v_rd_off(int d0, int ks, int half) { return d0 * 512 + ks * 4096 + half * 2048; }
__device__ __forceinline__ int crow(int r, int hi) { return (r & 3) + 8 * (r >> 2) + 4 * hi; }

__device__ __forceinline__ void partialSM(f32x16& p0, f32x16& p1, float& m_reg, float& mn, float& alpha) {
    float pmax = p0[0];
#pragma unroll
    for (int r = 1; r < 16; ++r) pmax = fmaxf(pmax, p0[r]);
#pragma unroll
    for (int r = 0; r < 16; ++r) pmax = fmaxf(pmax, p1[r]);
    { auto rr = __builtin_amdgcn_permlane32_swap(__float_as_uint(pmax), __float_as_uint(pmax), false, false);
      pmax = fmaxf(__uint_as_float(rr[0]), __uint_as_float(rr[1])); }
    if (__builtin_expect(__all((pmax - m_reg) <= THR2), 1)) { mn = m_reg; alpha = 1.f; }
    else { mn = fmaxf(m_reg, pmax); alpha = __builtin_amdgcn_exp2f(m_reg - mn); m_reg = mn; }
#pragma unroll
    for (int r = 0; r < 16; ++r) p0[r] = p0[r] - mn;
#pragma unroll
    for (int r = 0; r < 16; ++r) p1[r] = p1[r] - mn;
#pragma unroll
    for (int r = 0; r < 16; ++r) p0[r] = __builtin_amdgcn_exp2f(p0[r]);
}
__device__ __forceinline__ void partialSM2(f32x16& p0, f32x16& p1, float& m_reg, float& alpha) {
    float pmax = p0[0];
#pragma unroll
    for (int r = 1; r < 16; ++r) pmax = fmaxf(pmax, p0[r]);
#pragma unroll
    for (int r = 0; r < 16; ++r) pmax = fmaxf(pmax, p1[r]);
    { auto rr = __builtin_amdgcn_permlane32_swap(__float_as_uint(pmax), __float_as_uint(pmax), false, false);
      pmax = fmaxf(__uint_as_float(rr[0]), __uint_as_float(rr[1])); }
    if (__builtin_expect(__all(pmax <= THR2), 1)) { alpha = 1.f; }
    else { const float d = fmaxf(pmax, 0.f); alpha = __builtin_amdgcn_exp2f(-d); m_reg += d;
#pragma unroll
        for (int r = 0; r < 16; ++r) { p0[r] -= d; p1[r] -= d; } }
#pragma unroll
    for (int r = 0; r < 16; ++r) p0[r] = __builtin_amdgcn_exp2f(p0[r]);
}
__device__ __forceinline__ void finishSM(f32x16& p0, f32x16& p1, float alpha, float& l_reg, bf16x8& pa0, bf16x8& pa1, bf16x8& pa2, bf16x8& pa3) {
#pragma unroll
    for (int r = 0; r < 16; ++r) p1[r] = __builtin_amdgcn_exp2f(p1[r]);
    float ps = 0;
#pragma unroll
    for (int r = 0; r < 16; ++r) ps += p0[r];
#pragma unroll
    for (int r = 0; r < 16; ++r) ps += p1[r];
    { auto rr = __builtin_amdgcn_permlane32_swap(__float_as_uint(ps), __float_as_uint(ps), false, false);
      ps = __uint_as_float(rr[0]) + __uint_as_float(rr[1]); }
    l_reg = l_reg * alpha + ps;
#define PK4(P, B_, OUT) do { unsigned a0 = cvt_pk_bf16(P[B_+0], P[B_+1]), a1 = cvt_pk_bf16(P[B_+2], P[B_+3]);                          \
        unsigned b0 = cvt_pk_bf16(P[B_+4], P[B_+5]), b1 = cvt_pk_bf16(P[B_+6], P[B_+7]);                                             \
        auto r0 = __builtin_amdgcn_permlane32_swap(a0, b0, false, false); auto r1 = __builtin_amdgcn_permlane32_swap(a1, b1, false, false); \
        u32x4 w = {r0[0], r1[0], r0[1], r1[1]}; OUT = *reinterpret_cast<bf16x8*>(&w); } while (0)
    PK4(p0, 0, pa0); PK4(p0, 8, pa1); PK4(p1, 0, pa2); PK4(p1, 8, pa3);
#undef PK4
}
template <int KB>
__device__ __forceinline__ void qkt(f32x16& p0, f32x16& p1, const char* lds, int r32, int hi, const bf16x8* qr, const char* qrl, bool act, float cinit) {
    if (!act) { const float NEG = -__builtin_inff();
#pragma unroll
        for (int r = 0; r < 16; ++r) { p0[r] = NEG; p1[r] = NEG; } return; }
#pragma unroll
    for (int r = 0; r < 16; ++r) { p0[r] = cinit; p1[r] = cinit; }
    const char* kb[4];
#pragma unroll
    for (int dd = 0; dd < 4; ++dd) kb[dd] = lds + OFF_K + KB * SHM_K + KSWZ(r32, (dd * 16 + hi * 8) * 2);
#pragma unroll
    for (int d0 = 0; d0 < 8; ++d0) { const char* a = kb[d0 & 3] + (d0 >> 2) * 128;
        bf16x8 b0 = *reinterpret_cast<const bf16x8*>(a);
        bf16x8 b1 = *reinterpret_cast<const bf16x8*>(a + 32 * 256);
        p0 = __builtin_amdgcn_mfma_f32_32x32x16_bf16(b0, qr[d0], p0, 0, 0, 0);
        p1 = __builtin_amdgcn_mfma_f32_32x32x16_bf16(b1, qr[d0], p1, 0, 0, 0); }
#pragma unroll
    for (int dd = 0; dd < 4; ++dd) { const char* a = lds + OFF_R + KB * SHM_R + RSWZ(r32, (dd * 16 + hi * 8) * 2);
        bf16x8 b0 = *reinterpret_cast<const bf16x8*>(a);
        bf16x8 b1 = *reinterpret_cast<const bf16x8*>(a + 32 * 128);
        const bf16x8 qf = *reinterpret_cast<const bf16x8*>(qrl + dd * 1024);
        p0 = __builtin_amdgcn_mfma_f32_32x32x16_bf16(b0, qf, p0, 0, 0, 0);
        p1 = __builtin_amdgcn_mfma_f32_32x32x16_bf16(b1, qf, p1, 0, 0, 0); }
}
template <int VB>
__device__ __forceinline__ void pv_tile(f32x16* o, int vb0, bf16x8 pa0, bf16x8 pa1, bf16x8 pa2, bf16x8 pa3, bool act) {
    if (!act) return;
#define TRRD(dst, off) asm volatile("ds_read_b64_tr_b16 %0, %1 offset:%2" : "=&v"(dst) : "v"(vb0), "i"(off) : "memory")
#define PV_D0(d0) do { s16x4 l0, l1, l2, l3, h0, h1, h2, h3; constexpr int b_ = OFF_V + VB * SHM_V + v_rd_off(d0, 0, 0);   \
        TRRD(l0, b_); TRRD(h0, b_ + 2048); TRRD(l1, b_ + 4096); TRRD(h1, b_ + 6144); TRRD(l2, b_ + 8192); TRRD(h2, b_ + 10240); TRRD(l3, b_ + 12288); TRRD(h3, b_ + 14336); \
        asm volatile("s_waitcnt lgkmcnt(0)" ::: "memory"); SBAR();                                                              \
        o[d0] = __builtin_amdgcn_mfma_f32_32x32x16_bf16(pa0, (bf16x8){l0[0], l0[1], l0[2], l0[3], h0[0], h0[1], h0[2], h0[3]}, o[d0], 0, 0, 0);   \
        o[d0] = __builtin_amdgcn_mfma_f32_32x32x16_bf16(pa1, (bf16x8){l1[0], l1[1], l1[2], l1[3], h1[0], h1[1], h1[2], h1[3]}, o[d0], 0, 0, 0);   \
        o[d0] = __builtin_amdgcn_mfma_f32_32x32x16_bf16(pa2, (bf16x8){l2[0], l2[1], l2[2], l2[3], h2[0], h2[1], h2[2], h2[3]}, o[d0], 0, 0, 0);   \
        o[d0] = __builtin_amdgcn_mfma_f32_32x32x16_bf16(pa3, (bf16x8){l3[0], l3[1], l3[2], l3[3], h3[0], h3[1], h3[2], h3[3]}, o[d0], 0, 0, 0); } while (0)
    PV_D0(0); PV_D0(1); PV_D0(2); PV_D0(3);
#undef PV_D0
#undef TRRD
}
struct Tensors { const bf16_t* QN; const bf16_t* QR; const bf16_t* KN; const bf16_t* KR; const bf16_t* V; bf16_t* O; };
#define PK4(P, B_, OUT) do { unsigned a0 = cvt_pk_bf16(P[B_+0], P[B_+1]), a1 = cvt_pk_bf16(P[B_+2], P[B_+3]);                          \
        unsigned b0 = cvt_pk_bf16(P[B_+4], P[B_+5]), b1 = cvt_pk_bf16(P[B_+6], P[B_+7]);                                             \
        auto r0 = __builtin_amdgcn_permlane32_swap(a0, b0, false, false); auto r1 = __builtin_amdgcn_permlane32_swap(a1, b1, false, false); \
        u32x4 w = {r0[0], r1[0], r0[1], r1[1]}; OUT = *reinterpret_cast<bf16x8*>(&w); } while (0)
template <int KB> __device__ __forceinline__ bf16x8 kfrag(const char* lds, int r32, int hi, int g) {
    if (g < 16) { const int d0 = g >> 1; const char* a = lds + OFF_K + KB * SHM_K + KSWZ(r32, ((d0 & 3) * 16 + hi * 8) * 2) + (d0 >> 2) * 128 + (g & 1) * 32 * 256; return *reinterpret_cast<const bf16x8*>(a); }
    const int dd = (g - 16) >> 1; const char* a = lds + OFF_R + KB * SHM_R + RSWZ(r32, (dd * 16 + hi * 8) * 2) + (g & 1) * 32 * 128; return *reinterpret_cast<const bf16x8*>(a);
}
struct LBase { int kb[4], rb[4], qb; };
#define DSR(dst, base, off) asm volatile("ds_read_b128 %0, %1 offset:%2" : "=&v"(dst) : "v"(base), "i"(off) : "memory")
template <int KB, int G_> __device__ __forceinline__ void kfrag_issue(bf16x8& dst, const LBase& L) {
    if constexpr (G_ < 16) { constexpr int d0 = G_ >> 1; DSR(dst, L.kb[d0 & 3], OFF_K + KB * SHM_K + (d0 >> 2) * 128 + (G_ & 1) * 32 * 256); }
    else { constexpr int dd = (G_ - 16) >> 1; DSR(dst, L.rb[dd], KB * SHM_R + (G_ & 1) * 32 * 128); }
}
template <int KB> __device__ __forceinline__ void phase_a(f32x16& x0, f32x16& x1, f32x16& y0, f32x16& y1, float& l_reg, float alY, bf16x8& pa0, bf16x8& pa1, bf16x8& pa2, bf16x8& pa3,
                                                            const LBase& L, const bf16x8* qr, bool act, float cinit) {
    if (!act) cinit = -__builtin_inff();
#pragma unroll
    for (int r = 0; r < 16; ++r) { x0[r] = cinit; x1[r] = cinit; }
    bf16x8 kf[26]; bf16x8 qf[4]; float sacc = 0.f;
    kfrag_issue<KB, 0>(kf[0], L); kfrag_issue<KB, 1>(kf[1], L);
#define PA_GAP(g) do {                                                                                                          \
        if constexpr ((g) + 2 < 24) kfrag_issue<KB, ((g) + 2 < 24 ? (g) + 2 : 0)>(kf[(g) + 2], L);                              \
        if constexpr ((g) >= 14 && (g) < 22 && ((g) & 1) == 0) DSR(qf[((g) - 14) >> 1], L.qb, (((g) - 14) >> 1) * 1024);       \
        constexpr int wn_ = (g) < 14 ? 2 : ((g) < 22 ? 3 : ((g) == 22 ? 1 : 0));                                                \
        if constexpr ((g) < 16) { asm volatile("s_waitcnt lgkmcnt(%1)" : "+v"(kf[g]) : "i"(wn_) : "memory"); SBAR();            \
            if ((g) & 1) x1 = __builtin_amdgcn_mfma_f32_32x32x16_bf16(kf[g], qr[(g) >> 1], x1, 0, 0, 0); else x0 = __builtin_amdgcn_mfma_f32_32x32x16_bf16(kf[g], qr[(g) >> 1], x0, 0, 0, 0); \
            y0[g] = __builtin_amdgcn_exp2f(y0[g]); y1[g] = __builtin_amdgcn_exp2f(y1[g]); sacc += y0[g]; sacc += y1[g]; }       \
        else { asm volatile("s_waitcnt lgkmcnt(%2)" : "+v"(kf[g]), "+v"(qf[((g) - 16) >> 1]) : "i"(wn_) : "memory"); SBAR();    \
            if ((g) & 1) x1 = __builtin_amdgcn_mfma_f32_32x32x16_bf16(kf[g], qf[((g) - 16) >> 1], x1, 0, 0, 0); else x0 = __builtin_amdgcn_mfma_f32_32x32x16_bf16(kf[g], qf[((g) - 16) >> 1], x0, 0, 0, 0); \
            if ((g) == 16) PK4(y0, 0, pa0); if ((g) == 18) PK4(y0, 8, pa1); if ((g) == 20) PK4(y1, 0, pa2); if ((g) == 22) PK4(y1, 8, pa3); } \
        SBAR(); } while (0)
    PA_GAP(0); PA_GAP(1); PA_GAP(2); PA_GAP(3); PA_GAP(4); PA_GAP(5); PA_GAP(6); PA_GAP(7); PA_GAP(8); PA_GAP(9); PA_GAP(10); PA_GAP(11);
    PA_GAP(12); PA_GAP(13); PA_GAP(14); PA_GAP(15); PA_GAP(16); PA_GAP(17); PA_GAP(18); PA_GAP(19); PA_GAP(20); PA_GAP(21); PA_GAP(22); PA_GAP(23);
#undef PA_GAP
    { auto rr = __builtin_amdgcn_permlane32_swap(__float_as_uint(sacc), __float_as_uint(sacc), false, false); sacc = __uint_as_float(rr[0]) + __uint_as_float(rr[1]); }
    l_reg = l_reg * alY + sacc;
}
__device__ __forceinline__ void finish_tail(f32x16& y0, f32x16& y1, float& l_reg, float alY, bf16x8& pa0, bf16x8& pa1, bf16x8& pa2, bf16x8& pa3) {
    float sacc = 0.f;
#pragma unroll
    for (int r = 0; r < 16; ++r) { y0[r] = __builtin_amdgcn_exp2f(y0[r]); y1[r] = __builtin_amdgcn_exp2f(y1[r]); sacc += y0[r]; sacc += y1[r]; }
    PK4(y0, 0, pa0); PK4(y0, 8, pa1); PK4(y1, 0, pa2); PK4(y1, 8, pa3);
    { auto rr = __builtin_amdgcn_permlane32_swap(__float_as_uint(sacc), __float_as_uint(sacc), false, false); sacc = __uint_as_float(rr[0]) + __uint_as_float(rr[1]); }
    l_reg = l_reg * alY + sacc;
}
template <int VB, bool WITH_MAX> __device__ __forceinline__ void phase_b(f32x16* o, int vb0, bf16x8 pa0, bf16x8 pa1, bf16x8 pa2, bf16x8 pa3, f32x16& x0, f32x16& x1, float& m_reg, float& alpha) {
#define TRRD(dst, off) asm volatile("ds_read_b64_tr_b16 %0, %1 offset:%2" : "=&v"(dst) : "v"(vb0), "i"(off) : "memory")
#define PVG(d0) do { s16x4 l0, l1, l2, l3, h0, h1, h2, h3; constexpr int b_ = OFF_V + VB * SHM_V + v_rd_off(d0, 0, 0);   \
        TRRD(l0, b_); TRRD(h0, b_ + 2048); TRRD(l1, b_ + 4096); TRRD(h1, b_ + 6144); TRRD(l2, b_ + 8192); TRRD(h2, b_ + 10240); TRRD(l3, b_ + 12288); TRRD(h3, b_ + 14336); \
        asm volatile("s_waitcnt lgkmcnt(0)" ::: "memory"); SBAR();                                                              \
        o[d0] = __builtin_amdgcn_mfma_f32_32x32x16_bf16(pa0, (bf16x8){l0[0], l0[1], l0[2], l0[3], h0[0], h0[1], h0[2], h0[3]}, o[d0], 0, 0, 0);   \
        o[d0] = __builtin_amdgcn_mfma_f32_32x32x16_bf16(pa1, (bf16x8){l1[0], l1[1], l1[2], l1[3], h1[0], h1[1], h1[2], h1[3]}, o[d0], 0, 0, 0);   \
        o[d0] = __builtin_amdgcn_mfma_f32_32x32x16_bf16(pa2, (bf16x8){l2[0], l2[1], l2[2], l2[3], h2[0], h2[1], h2[2], h2[3]}, o[d0], 0, 0, 0);   \
        o[d0] = __builtin_amdgcn_mfma_f32_32x32x16_bf16(pa3, (bf16x8){l3[0], l3[1], l3[2], l3[3], h3[0], h3[1], h3[2], h3[3]}, o[d0], 0, 0, 0); } while (0)
    PVG(0);
    float pmax = 0.f;
    if constexpr (WITH_MAX) {
        pmax = x0[0];
#pragma unroll
        for (int r = 1; r < 16; ++r) pmax = fmaxf(pmax, x0[r]);
#pragma unroll
        for (int r = 0; r < 16; ++r) pmax = fmaxf(pmax, x1[r]);
    }
    SBAR(); PVG(1);
    if constexpr (WITH_MAX) { auto rr = __builtin_amdgcn_permlane32_swap(__float_as_uint(pmax), __float_as_uint(pmax), false, false); pmax = fmaxf(__uint_as_float(rr[0]), __uint_as_float(rr[1])); }
    SBAR(); PVG(2); SBAR(); PVG(3);
    alpha = 1.f;
    if constexpr (WITH_MAX) {
        if (__builtin_expect(!__all(pmax <= THR2), 0)) { const float d = fmaxf(pmax, 0.f); alpha = __builtin_amdgcn_exp2f(-d); m_reg += d;
#pragma unroll
            for (int r = 0; r < 16; ++r) { x0[r] -= d; x1[r] -= d; } }
    }
#undef PVG
#undef TRRD
}
__device__ __forceinline__ void attn_block(const Tensors& T, int b, int h, int qb, char* lds) {
    int tid = threadIdx.x; asm volatile("" : "+v"(tid));
    const int wid = __builtin_amdgcn_readfirstlane(tid >> 6), lane = tid & 63, r32 = lane & 31, hi = lane >> 5;
    const size_t base = (size_t)b * SEQ;
    const int q0 = qb * QB, NT = q0 / KVBLK + 4, qlo = q0 + wid * QBLK;
    float* ws = (float*)(lds + OFF_WS) + wid * 64; float* li_l = ws, * al_l = ws + 32;
    float m_reg = -1e30f, l_reg = 0; f32x16 o[4] = {};
    const int vb0 = (int)(uintptr_t)lds + v_rd_base(lane);
    unsigned ko[2], vo[2], ro;
#pragma unroll
    for (int jj = 0; jj < 2; ++jj) { const int ofs = (jj * 8 + wid) * 1024 + lane * 16;
        { const int row = ofs >> 8, colB = (ofs & 255) ^ ((row & 7) << 4); ko[jj] = (unsigned)(row * 2048 + (colB >> 1)); }
        { const int sub = ofs >> 9, within = ofs & 511, kk = ((sub >> 2) << 3) | (within >> 6), k = (kk & ~0xC) | ((kk & 4) << 1) | ((kk & 8) >> 1), c = (sub & 3) * 32 + ((within & 63) >> 1); vo[jj] = (unsigned)(k * 2048 + c); } }
    { const int ofs = wid * 1024 + lane * 16, row = ofs >> 7, colB = (ofs & 127) ^ ((row & 7) << 4); ro = (unsigned)(row * 64 + (colB >> 1)); }
    const bf16_t* Kh = T.KN + base * 2048 + h * 128; const bf16_t* Vh = T.V + base * 2048 + h * 128; const bf16_t* Rh = T.KR + base * 64;
    LAS unsigned char* l3 = (LAS unsigned char*)lds;
#define DMA_K(t, bf) do { const bf16_t* kp_ = Kh + (size_t)(t) * KVBLK * 2048; const bf16_t* rp_ = Rh + (size_t)(t) * KVBLK * 64;                                      \
        __builtin_amdgcn_global_load_lds((const unsigned*)(kp_ + ko[0]), (LAS unsigned*)(l3 + OFF_K + (bf) * SHM_K + wid * 1024), 16, 0, 0);                                 \
        __builtin_amdgcn_global_load_lds((const unsigned*)(kp_ + ko[1]), (LAS unsigned*)(l3 + OFF_K + (bf) * SHM_K + (8 + wid) * 1024), 16, 0, 0);                           \
        __builtin_amdgcn_global_load_lds((const unsigned*)(rp_ + ro), (LAS unsigned*)(l3 + OFF_R + (bf) * SHM_R + wid * 1024), 16, 0, 0); } while (0)
#define DMA_V(t, bf) do { const bf16_t* vp_ = Vh + (size_t)(t) * KVBLK * 2048;                                                                                           \
        __builtin_amdgcn_global_load_lds((const unsigned*)(vp_ + vo[0]), (LAS unsigned*)(l3 + OFF_V + (bf) * SHM_V + wid * 1024), 16, 0, 0);                                 \
        __builtin_amdgcn_global_load_lds((const unsigned*)(vp_ + vo[1]), (LAS unsigned*)(l3 + OFF_V + (bf) * SHM_V + (8 + wid) * 1024), 16, 0, 0); } while (0)
#define SYNC() do { asm volatile("s_waitcnt vmcnt(0) lgkmcnt(0)" ::: "memory"); __syncthreads(); } while (0)
#define RESC(a) do { if (__any((a) < 1.f)) { if (hi == 0) al_l[r32] = (a); asm volatile("s_waitcnt lgkmcnt(0)" ::: "memory");              \
                     for (int d_ = 0; d_ < 4; ++d_) for (int r = 0; r < 16; ++r) o[d_][r] *= al_l[crow(r, hi)]; } } while (0)
#define ACT(t) ((t) * KVBLK <= qlo)
    bf16x8 qr[8]; char* qrl = lds + OFF_QR + wid * 4096 + lane * 16;
    LBase LB;
#pragma unroll
    for (int dd = 0; dd < 4; ++dd) { LB.kb[dd] = (int)(uintptr_t)lds + KSWZ(r32, (dd * 16 + hi * 8) * 2); LB.rb[dd] = (int)(uintptr_t)lds + OFF_R + RSWZ(r32, (dd * 16 + hi * 8) * 2); }
    LB.qb = (int)(uintptr_t)lds + OFF_QR + wid * 4096 + lane * 16;
    { const size_t qrow = base + q0 + wid * QBLK + r32;
#pragma unroll
      for (int d0 = 0; d0 < 8; ++d0) qr[d0] = *(const bf16x8*)(T.QN + qrow * 2048 + h * 128 + d0 * 16 + hi * 8);
#pragma unroll
      for (int d0 = 0; d0 < 4; ++d0) *(bf16x8*)(qrl + d0 * 1024) = *(const bf16x8*)(T.QR + qrow * 1024 + h * 64 + d0 * 16 + hi * 8); }
    DMA_K(0, 0); SYNC();
    f32x16 pA0, pA1, pB0, pB1; float alA = 1.f, alB = 1.f; bf16x8 pa0, pa1, pa2, pa3;
    DMA_K(1, 1); DMA_V(0, 0);
    { float mn_; qkt<0>(pA0, pA1, lds, r32, hi, qr, qrl, true, 0.f);
      float pmax = pA0[0];
#pragma unroll
      for (int r = 1; r < 16; ++r) pmax = fmaxf(pmax, pA0[r]);
#pragma unroll
      for (int r = 0; r < 16; ++r) pmax = fmaxf(pmax, pA1[r]);
      { auto rr = __builtin_amdgcn_permlane32_swap(__float_as_uint(pmax), __float_as_uint(pmax), false, false); pmax = fmaxf(__uint_as_float(rr[0]), __uint_as_float(rr[1])); }
      m_reg = pmax; mn_ = pmax;
#pragma unroll
      for (int r = 0; r < 16; ++r) { pA0[r] -= mn_; pA1[r] -= mn_; } }
    SYNC();
#define STEP(X0, X1, alX, Y0, Y1, alY, t, KB, VB) do {                                                                         \
        if ((t) + 1 < NT) DMA_K((t) + 1, (KB) ^ 1); DMA_V(t, (VB) ^ 1); SBAR();                                               \
        phase_a<KB>(X0, X1, Y0, Y1, l_reg, alY, pa0, pa1, pa2, pa3, LB, qr, ACT(t), -m_reg); SBAR();                       \
        phase_b<VB, true>(o, vb0, pa0, pa1, pa2, pa3, X0, X1, m_reg, alX); SBAR();                                             \
        RESC(alX); SYNC(); } while (0)
    for (int t = 1; t + 1 < NT; t += 2) {
        STEP(pB0, pB1, alB, pA0, pA1, alA, t, 1, 0);
        STEP(pA0, pA1, alA, pB0, pB1, alB, t + 1, 0, 1);
    }
    STEP(pB0, pB1, alB, pA0, pA1, alA, NT - 1, 1, 0);
    finish_tail(pB0, pB1, l_reg, alB, pa0, pa1, pa2, pa3); SBAR();
    { float dm_, da_; phase_b<1, false>(o, vb0, pa0, pa1, pa2, pa3, pB0, pB1, dm_ = 0.f, da_); }
    if (hi == 0) li_l[r32] = l_reg; asm volatile("s_waitcnt lgkmcnt(0)" ::: "memory");
    float rli[16];
#pragma unroll
    for (int r = 0; r < 16; ++r) rli[r] = __builtin_amdgcn_rcpf(li_l[crow(r, hi)]);
    bf16_t* Ow = T.O + (base + q0 + wid * QBLK) * 2048 + h * 128;
    __syncthreads();
    { bf16_t* stg = (bf16_t*)(lds + OFF_V) + wid * 4096;
#pragma unroll
      for (int r = 0; r < 16; ++r) { const int orow = crow(r, hi);
#pragma unroll
          for (int d0 = 0; d0 < 4; ++d0) { const float v = o[d0][r] * rli[r]; stg[orow * 128 + d0 * 32 + r32] = (bf16_t)(cvt_pk_bf16(v, 0.f) & 0xffffu); } }
      asm volatile("s_waitcnt lgkmcnt(0)" ::: "memory");
#pragma unroll
      for (int i = 0; i < 8; ++i) { const int row = i * 4 + (lane >> 4), ch = lane & 15; const u32x4 v = *(const u32x4*)(stg + row * 128 + ch * 8); *(u32x4*)(Ow + (size_t)row * 2048 + ch * 8) = v; } }
    __syncthreads();
#undef DMA_K
#undef DMA_V
#undef SYNC
#undef RESC
#undef ACT
#undef STEP
}
#undef PK4
#undef DSR
#undef KSWZ
#undef RSWZ
#undef SBAR
}

namespace thin {
struct Ctx { int lane, wave, gw, ngw, gt, ngt; LAS unsigned char* lds; };

struct TJob { const float* W; const float* gain; bf16_t* dst; int K, N, ldd, kind; };
__device__ __forceinline__ bf16_t* dst_ptr(const TJob& J, int s) {
    int row = s, koff = 0;
    switch (J.kind) {
        case 1: row = s < 512 ? 512 + s : 1024 + 2 * ((s - 512) & 31) + ((s - 512) >> 5); break;
        case 2: { const int h = s / 192, d = s - h * 192; row = d < 128 ? h * 128 + d : 2048 + h * 64 + 2 * ((d - 128) & 31) + ((d - 128) >> 5); } break;
        case 3: koff = ((s & 255) >> 7) * 512; break;
        case 4: if (s >= 4096) { const int t = (s - 4096) >> 7, r = (s - 4096) & 127; row = 2048 + 256 * t + 128 + r; } else if (s >= 2048) { const int t = (s - 2048) >> 7, r = (s - 2048) & 127; row = 2048 + 256 * t + r; } break;
        default: break;
    }
    return J.dst + (size_t)row * J.ldd + koff;
}
__device__ __forceinline__ void titem_load(const TJob& J, int item, int lane, f32x4 (&v)[8]) {
    const int nblk = J.N / 32, kb = item / nblk, nb = item - kb * nblk, k0 = 64 * kb, s0 = 32 * nb; const int rs = lane >> 3, c4 = (lane & 7) * 4;
#pragma unroll
    for (int i = 0; i < 8; ++i) v[i] = *(const f32x4*)(J.W + (size_t)(k0 + i * 8 + rs) * J.N + s0 + c4);
}
__device__ __forceinline__ void titem_finish(const TJob& J, int item, LAS float* scr, int lane, const f32x4 (&v)[8]) {
    const int nblk = J.N / 32, kb = item / nblk, nb = item - kb * nblk, k0 = 64 * kb, s0 = 32 * nb; const int rs = lane >> 3, c4 = (lane & 7) * 4;
#pragma unroll
    for (int i = 0; i < 8; ++i) { const int kk = i * 8 + rs; const float gv = J.gain ? J.gain[k0 + kk] : 1.0f;
#pragma unroll
        for (int e = 0; e < 4; ++e) scr[kk * 33 + c4 + e] = v[i][e] * gv; }
    LDS_WAIT(); asm volatile("" ::: "memory");
    const int c = lane & 7;
#pragma unroll
    for (int j = 0; j < 4; ++j) { const int n = (lane >> 3) + 8 * j; const LAS float* s = scr + (8 * c) * 33 + n;
        u32x4 o; o.x = cvt_pk_bf16(s[0 * 33], s[1 * 33]); o.y = cvt_pk_bf16(s[2 * 33], s[3 * 33]); o.z = cvt_pk_bf16(s[4 * 33], s[5 * 33]); o.w = cvt_pk_bf16(s[6 * 33], s[7 * 33]);
        *(u32x4*)(dst_ptr(J, s0 + n) + k0 + 8 * c) = o; }
    LDS_WAIT(); asm volatile("" ::: "memory");
}
__device__ __forceinline__ void transpose_item(const TJob& J, int item, LAS float* scr, int lane) { f32x4 v[8]; titem_load(J, item, lane, v); titem_finish(J, item, scr, lane, v); }
__device__ __forceinline__ void zero_win(const Ctx& C, bf16_t* base, int rows, size_t ld, int ncols) {
    const int cpr = ncols / 8; const long total = (long)rows * cpr;
    for (long i = C.gt; i < total; i += C.ngt) { const long r = i / cpr; const int c = (int)(i - r * cpr); *(u32x4*)(base + r * ld + c * 8) = (u32x4){0u, 0u, 0u, 0u}; }
}
__device__ __forceinline__ void x_to_bf16(const Ctx& C, const float* xp, const float* xs, bf16_t* XB, float* ssq) {
    for (int row = C.gw; row < MT; row += C.ngw) {
        const float* src = row < MP ? xp + (size_t)row * DM : xs + (size_t)(row - MP) * DM;
        float s = 0.f;
#pragma unroll
        for (int j = 0; j < 8; ++j) { const f32x4 v = *(const f32x4*)(src + 4 * C.lane + 256 * j); s += epi::sq4(v);
            u32x2 w; w.x = cvt_pk_bf16(v[0], v[1]); w.y = cvt_pk_bf16(v[2], v[3]); *(u32x2*)(XB + (size_t)row * DM + 4 * C.lane + 256 * j) = w; }
        s = wave_sum(s);
        if (C.lane < 32) ssq[(size_t)row * 32 + C.lane] = C.lane == 0 ? s : 0.f;
    }
}
__device__ __forceinline__ void cs_table(const Ctx& C, float* cs) {
    for (int i = C.gt; i < NPOS * 32; i += C.ngt) { const int pos = i >> 5, p = i & 31;
        const float inv = powf(10000.0f, -(float)p / 32.0f); const float ang = (float)pos * inv; float sn, cn; sincosf(ang, &sn, &cn);
        cs[(size_t)i * 2] = cn; cs[(size_t)i * 2 + 1] = sn; }
}
__device__ __forceinline__ void citem_load(const float* ckv, int item, int lane, f32x4 (&v)[8]) {
    const int db = item & 15, kt = (item >> 4) & 63, jb = item >> 10;
    const float* src = ckv + ((size_t)jb * PAST + kt * 64) * 512 + db * 32; const int rs = lane >> 3, c4 = (lane & 7) * 4;
#pragma unroll
    for (int i = 0; i < 8; ++i) v[i] = *(const f32x4*)(src + (size_t)(i * 8 + rs) * 512 + c4);
}
__device__ __forceinline__ void citem_finish(bf16_t* KC, bf16_t* VT, int item, LAS float* scr, int lane, const f32x4 (&v)[8]) {
    const int db = item & 15, kt = (item >> 4) & 63, jb = item >> 10; const int rs = lane >> 3, c4 = (lane & 7) * 4;
#pragma unroll
    for (int i = 0; i < 8; ++i) { const int kk = i * 8 + rs;
#pragma unroll
        for (int e = 0; e < 4; ++e) scr[kk * 33 + c4 + e] = v[i][e]; }
    LDS_WAIT(); asm volatile("" ::: "memory");
    const int c = lane & 7;
    bf16_t* vt = VT + (size_t)jb * 512 * KEYP + (size_t)(db * 32) * KEYP + kt * 64;
#pragma unroll
    for (int j = 0; j < 4; ++j) { const int n = (lane >> 3) + 8 * j; const LAS float* s = scr + (8 * c) * 33 + n;
        u32x4 o; o.x = cvt_pk_bf16(s[0 * 33], s[1 * 33]); o.y = cvt_pk_bf16(s[2 * 33], s[3 * 33]); o.z = cvt_pk_bf16(s[4 * 33], s[5 * 33]); o.w = cvt_pk_bf16(s[6 * 33], s[7 * 33]);
        *(u32x4*)(vt + (size_t)n * KEYP + 8 * c) = o; }
    const int kq = lane & 3;
#pragma unroll
    for (int j = 0; j < 4; ++j) { const int key = (lane >> 2) + 16 * j; const LAS float* s = scr + key * 33 + 8 * kq;
        u32x4 o; o.x = cvt_pk_bf16(s[0], s[1]); o.y = cvt_pk_bf16(s[2], s[3]); o.z = cvt_pk_bf16(s[4], s[5]); o.w = cvt_pk_bf16(s[6], s[7]);
        *(u32x4*)(KC + ((size_t)jb * KEYP + kt * 64 + key) * QLD + db * 32 + 8 * kq) = o; }
    LDS_WAIT(); asm volatile("" ::: "memory");
}
__device__ __forceinline__ void cache_item(const float* ckv, bf16_t* KC, bf16_t* VT, int item, LAS float* scr, int lane) { f32x4 v[8]; citem_load(ckv, item, lane, v); citem_finish(KC, VT, item, scr, lane, v); }
__device__ __forceinline__ void cache_convert(const Ctx& C, const float* ckv, bf16_t* KC) {
    const long NR = (long)2 * DB * PAST;
    for (long r0 = C.gw; r0 < NR; r0 += 4L * C.ngw) { f32x4 a[4], b[4];
#pragma unroll
        for (int k = 0; k < 4; ++k) { const long r = r0 + (long)k * C.ngw; if (r < NR) { const float* src = ckv + r * 512 + 8 * C.lane; a[k] = *(const f32x4*)src; b[k] = *(const f32x4*)(src + 4); } }
#pragma unroll
        for (int k = 0; k < 4; ++k) { const long r = r0 + (long)k * C.ngw; if (r < NR) { const long jb = r >> 12; const int key = (int)(r & (PAST - 1));
            *(u32x4*)(KC + ((size_t)jb * KEYP + key) * QLD + 8 * C.lane) = epi::pack8(a[k], b[k]); } } }
}
__device__ __forceinline__ void krope_convert(const Ctx& C, const float* ckr, bf16_t* KC) {
    const long total = (long)2 * DB * PAST * 8;
    for (long i = C.gt; i < total; i += C.ngt) { const int c = (int)(i & 7); const long key = i >> 3; const long jb = key >> 12; const int k = (int)(key & (PAST - 1));
        const float* src = ckr + key * 64; const f32x4 a = *(const f32x4*)(src + 4 * c), b = *(const f32x4*)(src + 32 + 4 * c);
        u32x4 o; o.x = cvt_pk_bf16(a[0], b[0]); o.y = cvt_pk_bf16(a[1], b[1]); o.z = cvt_pk_bf16(a[2], b[2]); o.w = cvt_pk_bf16(a[3], b[3]);
        *(u32x4*)(KC + ((size_t)jb * KEYP + k) * QLD + 512 + 8 * c) = o; }
}
__device__ __forceinline__ void ckv_norm(const Ctx& C, const float* KVRAW, const float* ssqkv, const float* gkv, float* ockp, float* ocks, bf16_t* CKV, bf16_t* KC) {
    for (int row = C.gw; row < MT; row += C.ngw) {
        const f32x4 pa = *(const f32x4*)(ssqkv + (size_t)row * 8), pb = *(const f32x4*)(ssqkv + (size_t)row * 8 + 4);
        const float s = ((pa[0] + pa[1]) + (pa[2] + pa[3])) + ((pb[0] + pb[1]) + (pb[2] + pb[3]));
        const float r = 1.0f / sqrtf(s * (1.0f / 512.0f) + EPS);
#pragma unroll
        for (int j = 0; j < 2; ++j) { const int col = 4 * C.lane + 256 * j;
            const u32x2 rw = *(const u32x2*)((const bf16_t*)KVRAW + (size_t)row * 512 + col);
            const f32x4 v = (f32x4){__uint_as_float(rw.x << 16), __uint_as_float(rw.x & 0xffff0000u), __uint_as_float(rw.y << 16), __uint_as_float(rw.y & 0xffff0000u)} * r * *(const f32x4*)(gkv + col);
            u32x2 w; w.x = cvt_pk_bf16(v[0], v[1]); w.y = cvt_pk_bf16(v[2], v[3]);
            if (row < MP) { *(f32x4*)(ockp + (size_t)row * 512 + col) = v; *(u32x2*)(CKV + (size_t)row * 512 + col) = w; }
            else { const int tok = row - MP, b = tok >> 5, t = tok & 31; *(f32x4*)(ocks + (size_t)tok * 512 + col) = v;
                *(u32x2*)(KC + ((size_t)b * KEYP + PAST + t) * QLD + col) = w; } }
    }
}
__device__ __forceinline__ void softmax_rows(const Ctx& C, const bf16_t* S, bf16_t* P) {
    for (int row = C.gw; row < DB * 512; row += C.ngw) {
        const bf16_t* sp = S + (size_t)row * KEYP + 8 * C.lane; float v[9][8]; float mx = -__builtin_inff();
#pragma unroll
        for (int i = 0; i < 9; ++i) { if (i < 8 || C.lane < 4) { const u32x4 w = *(const u32x4*)(sp + 512 * i);
#pragma unroll
                for (int e = 0; e < 4; ++e) { v[i][2 * e] = __uint_as_float(w[e] << 16); v[i][2 * e + 1] = __uint_as_float(w[e] & 0xffff0000u); mx = fmaxf(mx, fmaxf(v[i][2 * e], v[i][2 * e + 1])); } }
            else {
#pragma unroll
                for (int e = 0; e < 8; ++e) v[i][e] = 0.f; } }
        mx = wave_max(mx); float l = 0.f;
#pragma unroll
        for (int i = 0; i < 9; ++i) { if (i < 8 || C.lane < 4) {
#pragma unroll
                for (int e = 0; e < 8; ++e) { v[i][e] = __builtin_amdgcn_exp2f(v[i][e] - mx); l += v[i][e]; } } }
        l = wave_sum(l); const float il = 1.0f / l;
        bf16_t* pp = P + (size_t)row * KEYP + 8 * C.lane;
#pragma unroll
        for (int i = 0; i < 9; ++i) { if (i < 8 || C.lane < 32) { u32x4 w;
#pragma unroll
                for (int e = 0; e < 4; ++e) w[e] = cvt_pk_bf16(v[i][2 * e] * il, v[i][2 * e + 1] * il);
                *(u32x4*)(pp + 512 * i) = w; } }
    }
}
__device__ __forceinline__ void rowsum_inv(const Ctx& C, const float* LP, float* IL, bool exact_ran) {
    for (int row = C.gw; row < DB * 512; row += C.ngw) {
        float s = LP[(size_t)row * LPP + C.lane] + (C.lane < 4 ? LP[(size_t)row * LPP + 64 + C.lane] : 0.f);
        s = wave_sum(s);
        if (C.lane == 0) IL[row] = exact_ran ? 1.0f : 1.0f / s; }
}
__device__ __forceinline__ void unpack8(const u32x4 w, float (&f)[8]) {
#pragma unroll
    for (int e = 0; e < 4; ++e) { f[2 * e] = __uint_as_float(w[e] << 16); f[2 * e + 1] = __uint_as_float(w[e] & 0xffff0000u); }
}
__device__ __forceinline__ void conv_pass(const Ctx& C, const bf16_t* GB, const bf16_t* U, const float* cw  , const float* st  , bf16_t* A2) {
    const long total = (long)MT * 256;
    for (long i = C.gt; i < total; i += C.ngt) { const int row = (int)(i >> 8), c = (int)(i & 255) * 8;
        float g[8], u0[8], u1[8], u2[8];
        unpack8(*(const u32x4*)(GB + (size_t)row * DM + c), g); unpack8(*(const u32x4*)(U + (size_t)row * DM + c), u2);
        int t; const float* s0 = nullptr;
        if (row < MP) t = row & (SEQ - 1); else { const int tok = row - MP; t = tok & 31; s0 = st + (size_t)(tok >> 5) * 2 * DM + c; }
        if (t >= 1) unpack8(*(const u32x4*)(U + (size_t)(row - 1) * DM + c), u1);
        else if (s0) { const f32x4 a = *(const f32x4*)(s0 + DM), b = *(const f32x4*)(s0 + DM + 4);
#pragma unroll
            for (int e = 0; e < 4; ++e) { u1[e] = a[e]; u1[4 + e] = b[e]; } }
        else {
#pragma unroll
            for (int e = 0; e < 8; ++e) u1[e] = 0.f; }
        if (t >= 2) unpack8(*(const u32x4*)(U + (size_t)(row - 2) * DM + c), u0);
        else if (s0) { const float* h = s0 + (size_t)t * DM; const f32x4 a = *(const f32x4*)(h), b = *(const f32x4*)(h + 4);
#pragma unroll
            for (int e = 0; e < 4; ++e) { u0[e] = a[e]; u0[4 + e] = b[e]; } }
        else {
#pragma unroll
            for (int e = 0; e < 8; ++e) u0[e] = 0.f; }
        float o[8];
#pragma unroll
        for (int e = 0; e < 8; ++e) o[e] = g[e] * (cw[c + e] * u0[e] + cw[DM + c + e] * u1[e] + cw[2 * DM + c + e] * u2[e]);
        u32x4 w; w.x = cvt_pk_bf16(o[0], o[1]); w.y = cvt_pk_bf16(o[2], o[3]); w.z = cvt_pk_bf16(o[4], o[5]); w.w = cvt_pk_bf16(o[6], o[7]);
        *(u32x4*)(A2 + (size_t)row * DM + c) = w; }
}
__device__ __forceinline__ void resid_finalize(const Ctx& C, const float* slab_, bf16_t* XB, float* ssq) {
    const bf16_t* slab = (const bf16_t*)slab_;
    for (int task = C.gw; task < MS * 2; task += C.ngw) { const int tok = task >> 1, half = task & 1, row = MP + tok; float s = 0.f;
#pragma unroll
        for (int j = 0; j < 2; ++j) { const int col = half * 1024 + 8 * C.lane + 512 * j; const u32x4 xo = *(const u32x4*)(XB + (size_t)row * DM + col);
            f32x4 v0 = (f32x4){__uint_as_float(xo.x << 16), __uint_as_float(xo.x & 0xffff0000u), __uint_as_float(xo.y << 16), __uint_as_float(xo.y & 0xffff0000u)};
            f32x4 v1 = (f32x4){__uint_as_float(xo.z << 16), __uint_as_float(xo.z & 0xffff0000u), __uint_as_float(xo.w << 16), __uint_as_float(xo.w & 0xffff0000u)};
            u32x4 p[8];
#pragma unroll
            for (int k = 0; k < 8; ++k) p[k] = *(const u32x4*)(slab + ((size_t)k * MS + tok) * DM + col);
#pragma unroll
            for (int k = 0; k < 8; ++k) {
                v0 += (f32x4){__uint_as_float(p[k].x << 16), __uint_as_float(p[k].x & 0xffff0000u), __uint_as_float(p[k].y << 16), __uint_as_float(p[k].y & 0xffff0000u)};
                v1 += (f32x4){__uint_as_float(p[k].z << 16), __uint_as_float(p[k].z & 0xffff0000u), __uint_as_float(p[k].w << 16), __uint_as_float(p[k].w & 0xffff0000u)}; }
            *(u32x4*)(XB + (size_t)row * DM + col) = epi::pack8(v0, v1); s += epi::sq4(v0) + epi::sq4(v1); }
        s = wave_sum(s);
        if (C.lane < 16) ssq[(size_t)row * 32 + half * 16 + C.lane] = C.lane == 0 ? s : 0.f; }
}
__device__ __forceinline__ void final_norm(const Ctx& C, const bf16_t* XB, const float* ssq, const float* g, float* yp, float* ys) {
    for (int row = C.gw; row < MT; row += C.ngw) {
        float s = C.lane < 32 ? ssq[(size_t)row * 32 + C.lane] : 0.f; s = wave_sum(s);
        const float r = 1.0f / sqrtf(s * (1.0f / DM) + EPS);
        float* dst = row < MP ? yp + (size_t)row * DM : ys + (size_t)(row - MP) * DM;
#pragma unroll
        for (int j = 0; j < 4; ++j) { const int col = 8 * C.lane + 512 * j; const u32x4 w = *(const u32x4*)(XB + (size_t)row * DM + col);
            const f32x4 a = (f32x4){__uint_as_float(w.x << 16), __uint_as_float(w.x & 0xffff0000u), __uint_as_float(w.y << 16), __uint_as_float(w.y & 0xffff0000u)};
            const f32x4 b = (f32x4){__uint_as_float(w.z << 16), __uint_as_float(w.z & 0xffff0000u), __uint_as_float(w.w << 16), __uint_as_float(w.w & 0xffff0000u)};
            *(f32x4*)(dst + col) = a * r * *(const f32x4*)(g + col); *(f32x4*)(dst + col + 4) = b * r * *(const f32x4*)(g + col + 4); }
    }
}
}

#define XB_TMO      128
#define XB_XCNT(j)  (256  + 64 * (j))
#define XB_XSUB(j)  (1280 + 64 * (j))
#define XB_XGEN(j)  (2304 + 64 * (j))
#define XB_TOP      3328
#define XB_TOPGEN   3392
#define XCD_BAR_WORDS 3456
#define XB_SPIN_CAP (1u << 18)

__device__ __forceinline__ unsigned xb_ld(unsigned* p)              { return __hip_atomic_load(p, __ATOMIC_RELAXED, __HIP_MEMORY_SCOPE_AGENT); }
__device__ __forceinline__ unsigned xb_add(unsigned* p, unsigned v) { return __hip_atomic_fetch_add(p, v, __ATOMIC_RELAXED, __HIP_MEMORY_SCOPE_AGENT); }
__device__ __forceinline__ unsigned xb_xcc_id() { return (unsigned)__builtin_amdgcn_s_getreg((3 << 11) | 20) & 0xFu; }
#define XB_SPIN(cond, bar) do { unsigned _sp = 0; while (cond) { __builtin_amdgcn_s_sleep(1); \
    if ((++_sp & 255u) == 0u) { if (xb_ld(&(bar)[XB_TMO])) break; if (_sp > XB_SPIN_CAP) { atomicAdd(&(bar)[XB_TMO], 1u); break; } } } } while (0)

struct XcdBarrier {
    unsigned* bar; unsigned x;
    volatile LAS unsigned* st;
};

__device__ __forceinline__ XcdBarrier xcd_barrier_post(unsigned* bar, volatile LAS unsigned* st) {
    XcdBarrier b; b.bar = bar; b.x = xb_xcc_id(); b.st = st;
    if (threadIdx.x == 0) (void)xb_add(&bar[XB_XCNT(b.x)], 1u);
    return b;
}
__device__ __forceinline__ void xcd_barrier_complete(unsigned* bar, unsigned x, unsigned& nloc, unsigned& nx) {
    const unsigned G = gridDim.x * gridDim.y * gridDim.z;
    unsigned sum, cnt, mine, sp = 0u;
    for (;;) {
        sum = 0u; cnt = 0u; mine = 0u;
#pragma unroll
        for (unsigned j = 0; j < 16; ++j) { const unsigned c = xb_ld(&bar[XB_XCNT(j)]); sum += c; cnt += (c > 0u) ? 1u : 0u; mine = (j == x) ? c : mine; }
        if (sum == G) break;
        __builtin_amdgcn_s_sleep(1);
        if ((++sp & 255u) == 0u) { if (xb_ld(&bar[XB_TMO])) break; if (sp > XB_SPIN_CAP) { atomicAdd(&bar[XB_TMO], 1u); break; } }
    }
    nloc = mine > 0u ? mine : 1u; nx = cnt > 0u ? cnt : 1u;
}

__device__ __forceinline__ void xcd_barrier(const XcdBarrier& b) {
    asm volatile("s_waitcnt vmcnt(0)" ::: "memory");
    __syncthreads();
    if (threadIdx.x == 0) {
        unsigned* bar = b.bar;
        __builtin_amdgcn_s_waitcnt(0);
        unsigned nloc = b.st[0], nx = b.st[1];
        if (nloc == 0u) { xcd_barrier_complete(bar, b.x, nloc, nx); b.st[0] = nloc; b.st[1] = nx; }
        const unsigned old = xb_add(&bar[XB_XSUB(b.x)], 1u);
        const unsigned gen = old / nloc;
        if (old + 1u == (gen + 1u) * nloc) {
            __builtin_amdgcn_fence(__ATOMIC_RELEASE, "agent");
            asm volatile("s_waitcnt vmcnt(0)" ::: "memory");
            const unsigned og = xb_add(&bar[XB_TOP], 1u);
            const unsigned tg = og / nx;
            if (og + 1u == (tg + 1u) * nx) xb_add(&bar[XB_TOPGEN], 1u);
            else XB_SPIN(xb_ld(&bar[XB_TOPGEN]) == tg, bar);
            __builtin_amdgcn_fence(__ATOMIC_ACQUIRE, "agent");
            xb_add(&bar[XB_XGEN(b.x)], 1u);
            asm volatile("s_waitcnt vmcnt(0)" ::: "memory");
        } else {
            XB_SPIN(xb_ld(&bar[XB_XGEN(b.x)]) == gen, bar);
            __builtin_amdgcn_fence(__ATOMIC_ACQUIRE, "agent");
            asm volatile("s_waitcnt vmcnt(0)" ::: "memory");
        }
    }
    __syncthreads();
}

constexpr int NWAVES = 8;
constexpr int RING_BYTES = 131072, MISC_OFF = RING_BYTES + 320, LDS_BYTES = 147456;
constexpr int N_PHASES = 38;

struct Args {
    const float *x_prompt, *x_sample, *cache_ckv, *cache_krope, *state_conv, *norm_mix, *w_dq, *g_q, *w_uq, *w_dkv, *g_kv, *w_uk, *w_uv, *w_o, *w_in, *conv_w, *w_out, *norm_ffn, *w_ff1, *w_ff2, *norm_final;
    float* out; unsigned char* ws; int ph_lo, ph_hi;
};

struct SchedQlat {
    int G, c;
    __device__ __forceinline__ bool next(int i, pg8::Unit& u, size_t& aoff, size_t& boff, int& unt) const { const int L = i * G + c; if (L >= 128) return false;
        u.z = L >> 3; u.pm = (L >> 1) & 3; u.pn = L & 1; aoff = ((size_t)(MP + u.pm * 256) * 2048 + u.z * 128) * 2; boff = ((size_t)(u.pn * 256) * 2048 + u.z * 128) * 2; return true; }
};
struct SchedScores {
    int G, c;
    __device__ __forceinline__ bool next(int i, pg8::Unit& u, size_t& aoff, size_t& boff, int& unt) const { const int L = i * G + c; if (L >= DB * 34) return false;
        u.z = L / 34; const int r = L - u.z * 34; u.pm = r / 17; u.pn = r - u.pm * 17;
        aoff = ((size_t)(u.z * 512 + u.pm * 256) * QLD) * 2; boff = ((size_t)(u.z * KEYP + u.pn * 256) * QLD) * 2; return true; }
};
struct SchedPV {
    int G, c;
    __device__ __forceinline__ bool next(int i, pg8::Unit& u, size_t& aoff, size_t& boff, int& unt) const { int L = i * G + c; if (L >= DB * 4) return false;
        if (G == 256) { const int x = c & 7, s = c >> 3; L = ((x + 8 * (s >> 1)) << 1) | (s & 1); }
        u.z = L >> 2; u.pm = (L >> 1) & 1; u.pn = L & 1;
        aoff = ((size_t)(u.z * 512 + u.pm * 256) * KEYP) * 2; boff = ((size_t)u.z * KEYP * QLD + u.pn * 256) * 2; return true; }
};
struct SchedO2 {
    int G, c;
    __device__ __forceinline__ bool next(int i, pg8::Unit& u, size_t& aoff, size_t& boff, int& unt) const { const int L = i * G + c; if (L >= 32) return false;
        u.z = 0; u.pm = L >> 3; u.pn = L & 7; aoff = ((size_t)(u.pm * 256) * 8192 + u.pn * 1024) * 2; boff = ((size_t)(u.pn * 256) * 1024) * 2; return true; }
};


struct SchedResid {
    pg8::SchedMN P; int G, c, nt8, L0; size_t astep, bstep; bool krev;
    __device__ __forceinline__ void init(int G_, int c_, int lda, int ldb, int nt, bool krev_, int L0_ = 0) { G = G_; c = c_; krev = krev_; L0 = L0_; nt8 = nt / 8; astep = (size_t)256 * lda * 2; bstep = (size_t)256 * ldb * 2; P.init(MP / 256, 8, G_, c_, astep, bstep, lda > 2048 ? 4 : 8); }
    __device__ __forceinline__ bool next(int i, pg8::Unit& u, size_t& aoff, size_t& boff, int& unt) const {
        const int L = i * G + c + L0;
        if (L < 512) { unt = nt8 * 8; const bool ok = P.map(L, u, aoff, boff); if (krev && (i & 1) == 0) { aoff += (size_t)(nt8 * 8 - 1) * 128; boff += (size_t)(nt8 * 8 - 1) * 128; unt = -unt; } return ok; }
        const int s = L - 512; if (s >= 256) return false;
        const int ks = s & 7; u.pn = (s >> 3) & 7; u.pm = 64 + (s >> 6); u.z = 1 + ks; unt = nt8;
        aoff = (size_t)u.pm * astep + (size_t)ks * nt8 * 128; boff = (size_t)u.pn * bstep + (size_t)ks * nt8 * 128; return true; }
};
struct SchedEarlyMix {
    pg8::SchedMN P; int c2;
    __device__ __forceinline__ void init(int G_, int bx) { c2 = bx - 128; P.init(MP / 256, 8, G_, bx, (size_t)256 * 2048 * 2, (size_t)256 * 2048 * 2); }
    __device__ __forceinline__ bool next(int i, pg8::Unit& u, size_t& aoff, size_t& boff, int& unt) const { if (c2 < 0 || i >= 2) return false; return P.map((long)i * 128 + c2, u, aoff, boff); }
};

__device__ __forceinline__ const Args& opq_args() { auto p = __builtin_amdgcn_kernarg_segment_ptr(); asm volatile("" : "+s"(p)); return *(const Args*)p; }
#define WSP(T, OFF) ((T*)(ws + (OFF)))
#define CS WSP(float, WS_CS)
#define SSQ WSP(float, WS_SSQ)
#define SSQCQ WSP(float, WS_SSQCQ)
#define SSQKV WSP(float, WS_SSQKV)
#define X WSP(float, WS_X)
#define XB WSP(bf16_t, WS_XB)
#define CQ WSP(bf16_t, WS_CQ)
#define KVRAW WSP(float, WS_KVRAW)
#define CKV WSP(bf16_t, WS_CKV)
#define KR WSP(bf16_t, WS_KR)
#define QN WSP(bf16_t, WS_QN)
#define QR WSP(bf16_t, WS_QR)
#define KN WSP(bf16_t, WS_KN)
#define VV WSP(bf16_t, WS_V)
#define GB WSP(bf16_t, WS_GB)
#define UU WSP(bf16_t, WS_U)
#define OB WSP(bf16_t, WS_O)
#define QL WSP(bf16_t, WS_QL)
#define OL WSP(bf16_t, WS_OL)
#define KC WSP(bf16_t, WS_KC)
#define VT WSP(bf16_t, WS_VT)
#define SS WSP(float, WS_S)
#define HB WSP(bf16_t, WS_HB)
#define PP WSP(bf16_t, WS_P)
#define W1 WSP(bf16_t, WS_W1)
#define W2 WSP(bf16_t, WS_W2)
#define W3 WSP(bf16_t, WS_W3)
#define WUK WSP(bf16_t, WS_WUK)
#define W5 WSP(bf16_t, WS_W5)
#define W6 WSP(bf16_t, WS_W6)
#define W10 WSP(bf16_t, WS_W10)
#define W9 WSP(bf16_t, WS_W9)
#define W7 WSP(bf16_t, WS_W7)
#define W8 WSP(bf16_t, WS_W8)

__global__ void __launch_bounds__(NWAVES * 64, 2) mk_fwd(Args args_) {
    extern __shared__ __attribute__((aligned(16))) unsigned char lds_raw[];
    LAS unsigned char* lds = (LAS unsigned char*)lds_raw;
    volatile LAS unsigned* MISC = (volatile LAS unsigned*)(lds + MISC_OFF);
    const int tid = threadIdx.x;
    const int G0 = gridDim.x, bx0 = blockIdx.x;
    unsigned* ctl = (unsigned*)(args_.ws + WS_CTL);
    for (int u = tid; u < (LDS_BYTES - RING_BYTES) / 4; u += NWAVES * 64) ((LAS unsigned*)(lds + RING_BYTES))[u] = 0u;
    __syncthreads();
    const int lo = args_.ph_lo, hi = args_.ph_hi;
    const bool use_bar = (hi - lo) > 1;
    XcdBarrier bar; bar.bar = ctl + CW_BAR; bar.x = 0; bar.st = nullptr;
    if (use_bar) bar = xcd_barrier_post(ctl + CW_BAR, MISC + 8);

    int ph = 0;
#ifndef SITE_MASK
#define SITE_MASK 0xffffffffu
#endif
#define SITE(k) (((SITE_MASK) >> (k)) & 1u)
#ifndef REPEAT_MASK
#define REPEAT_MASK 0u
#endif
#define REPS(k) (1 + (int)(((REPEAT_MASK) >> (k)) & 1u) * REPEAT_N)
#ifndef REPEAT_N
#define REPEAT_N 1
#endif
#define PH_ON() (lo <= ph && ph < hi)
#define ssq_mix (SSQ + (size_t)(2 * i) * MT * 32)
#define ssq_ffn (SSQ + (size_t)(2 * i + 1) * MT * 32)
#define ssq_next (SSQ + (size_t)(2 * i + 2) * MT * 32)
#define KCj (KC + (size_t)j * DB * KEYP * QLD)
#define VTj (VT + (size_t)j * DB * 512 * KEYP)
#define CTX_LOCALS int tid_ = threadIdx.x; asm volatile("" : "+v"(tid_)); thin::Ctx C; C.lane = tid_ & 63; C.wave = __builtin_amdgcn_readfirstlane(tid_ >> 6); C.gw = bx * NWAVES + C.wave; C.ngw = G * NWAVES; C.gt = bx * (NWAVES * 64) + tid_; C.ngt = G * NWAVES * 64; C.lds = lds
#define SITE_LOCALS int G = G0, bx = bx0; asm volatile("" : "+s"(G), "+s"(bx)); const Args& args = opq_args(); unsigned char* const ws = args.ws; float* const out = args.out; (void)ws; (void)out
#define PH_END() do { if (use_bar && lo <= ph && ph + 1 < hi) xcd_barrier(bar); ++ph; } while (0)

    if (SITE(0) && PH_ON()) for (int rep_ = 0; rep_ < REPS(0); ++rep_) { SITE_LOCALS; CTX_LOCALS; const int lane = C.lane, wave = C.wave;
        LAS float* scr = (LAS float*)(lds + wave * 16384);
        thin::cache_convert(C, args.cache_ckv, KC);
        thin::krope_convert(C, args.cache_krope, KC);
        for (int jr = 0; jr < 26; ++jr) { const int job = 25 - jr;
            thin::TJob J; J.gain = nullptr; J.kind = 0;
            if (job < 14) { const int j = job / 7, k = job - j * 7;
                switch (k) {
                    case 0: J.W = args.w_dq + (size_t)j * 2048 * 512; J.K = 2048; J.N = 512; J.gain = args.norm_mix + (size_t)(2 * j) * DM; J.dst = W1 + (size_t)j * 1280 * 2048; J.ldd = 2048; break;
                    case 1: J.W = args.w_dkv + (size_t)j * 2048 * 576; J.K = 2048; J.N = 576; J.gain = args.norm_mix + (size_t)(2 * j) * DM; J.dst = W1 + (size_t)j * 1280 * 2048; J.ldd = 2048; J.kind = 1; break;
                    case 2: J.W = args.w_uq + (size_t)j * 512 * 3072; J.K = 512; J.N = 3072; J.gain = args.g_q + (size_t)j * 512; J.dst = W2 + (size_t)j * 3072 * 512; J.ldd = 512; J.kind = 2; break;
                    case 3: J.W = args.w_uk + (size_t)j * 512 * 2048; J.K = 512; J.N = 2048; J.dst = W3 + (size_t)j * 4096 * 512; J.ldd = 512; break;
                    case 4: J.W = args.w_uv + (size_t)j * 512 * 2048; J.K = 512; J.N = 2048; J.dst = W3 + (size_t)j * 4096 * 512 + (size_t)2048 * 512; J.ldd = 512; break;
                    case 5: J.W = args.w_uv + (size_t)j * 512 * 2048; J.K = 512; J.N = 2048; J.dst = W5 + (size_t)j * 2048 * 1024; J.ldd = 1024; J.kind = 3; break;
                    default: J.W = args.w_o + (size_t)j * 2048 * 2048; J.K = 2048; J.N = 2048; J.dst = W6 + (size_t)j * 2048 * 2048; J.ldd = 2048; break;
                } }
            else if (job < 18) { const int j = (job - 14) >> 1;
                if (((job - 14) & 1) == 0) { J.W = args.w_in + (size_t)j * 2048 * 6144; J.K = 2048; J.N = 6144; J.gain = args.norm_mix + (size_t)(2 * j + 1) * DM; J.dst = W9 + (size_t)j * 6144 * 2048; J.ldd = 2048; J.kind = 4; }
                else { J.W = args.w_out + (size_t)j * 2048 * 2048; J.K = 2048; J.N = 2048; J.dst = W10 + (size_t)j * 2048 * 2048; J.ldd = 2048; } }
            else { const int i = (job - 18) >> 1;
                if (((job - 18) & 1) == 0) { J.W = args.w_ff1 + (size_t)i * 2048 * 8192; J.K = 2048; J.N = 8192; J.gain = args.norm_ffn + (size_t)i * DM; J.dst = W7 + (size_t)i * 8192 * 2048; J.ldd = 2048; }
                else { J.W = args.w_ff2 + (size_t)i * 8192 * 2048; J.K = 8192; J.N = 2048; J.dst = W8 + (size_t)i * 2048 * 8192; J.ldd = 8192; } }
            const int nitems = (J.K / 64) * (J.N / 32);
            for (int it = C.gw; it < nitems; it += C.ngw) thin::transpose_item(J, it, scr, lane);
        }
        for (long i = C.gt; i < (long)2 * 512 * 2048 / 8; i += C.ngt) { const f32x4 a = *(const f32x4*)(args.w_uk + i * 8), b = *(const f32x4*)(args.w_uk + i * 8 + 4); *(u32x4*)(WUK + i * 8) = epi::pack8(a, b); }
        for (int j = 0; j < 2; ++j) {
            thin::zero_win(C, W1 + (size_t)j * 1280 * 2048 + (size_t)1088 * 2048, 192, 2048, 2048);
            for (int pn = 0; pn < 8; ++pn) { thin::zero_win(C, W5 + (size_t)j * 2048 * 1024 + (size_t)(pn * 256) * 1024 + 512, 128, 1024, 512);
                                              thin::zero_win(C, W5 + (size_t)j * 2048 * 1024 + (size_t)(pn * 256 + 128) * 1024, 128, 1024, 512); }
            thin::zero_win(C, KC + (size_t)j * DB * KEYP * QLD + 576, DB * KEYP, QLD, 64);
            for (int b = 0; b < DB; ++b) thin::zero_win(C, KC + ((size_t)(j * DB + b) * KEYP + NKEY) * QLD, KEYP - NKEY, QLD, 576);
        }
        thin::zero_win(C, QL + 576, MS * 16, QLD, 64);
        thin::cs_table(C, CS);
        thin::x_to_bf16(C, args.x_prompt, args.x_sample, XB, SSQ);
    }
    PH_END();

    for (int i = 0; i < DEPTH; ++i) {
        const int j = i >> 1;
        if ((i & 1) == 0) {
            if (SITE(1) && PH_ON()) for (int rep_ = 0; rep_ < REPS(1); ++rep_) { SITE_LOCALS;
                pg8::Gemm g{XB, W1 + (size_t)j * 1280 * 2048, 2048, 2048, 32}; pg8::SchedMN S; S.init(MT / 256, 5, G, bx, (size_t)256 * 2048 * 2, (size_t)256 * 2048 * 2);
                epi::EpiW1 E{ssq_mix, CS, CQ, SSQCQ, KVRAW, SSQKV, KR, KCj, out + O_KRP + (size_t)j * MP * 64, out + O_KRS + (size_t)j * MS * 64};
                pg8::gemm_phase(lds, g, S, E);
            }
            PH_END();
            if (SITE(2) && PH_ON()) for (int rep_ = 0; rep_ < REPS(2); ++rep_) { SITE_LOCALS; CTX_LOCALS; thin::ckv_norm(C, KVRAW, SSQKV, args.g_kv + (size_t)j * 512, out + O_CKVP + (size_t)j * MP * 512, out + O_CKVS + (size_t)j * MS * 512, CKV, KCj); }
            if (SITE(3) && PH_ON()) for (int rep_ = 0; rep_ < REPS(3); ++rep_) { SITE_LOCALS;
                pg8::Gemm g{CQ, W2 + (size_t)j * 3072 * 512, 512, 512, 8}; pg8::SchedMN S; S.init(MT / 256, 12, G, bx, (size_t)256 * 512 * 2, (size_t)256 * 512 * 2);
                epi::EpiW2 E{SSQCQ, CS, QN, QR, QL};
                pg8::gemm_phase(lds, g, S, E);
            }
            PH_END();
            if (SITE(4) && PH_ON()) for (int rep_ = 0; rep_ < REPS(4); ++rep_) { SITE_LOCALS;
                { pg8::Gemm g{CKV, W3 + (size_t)j * 4096 * 512, 512, 512, 8}; pg8::SchedMN S; S.init(MP / 256, 16, G, bx, (size_t)256 * 512 * 2, (size_t)256 * 512 * 2);
                  epi::EpiBf16<epi::MapW3> E{epi::MapW3{KN, VV}}; pg8::gemm_phase(lds, g, S, E); }
                { pg8::Gemm g{QN, WUK + (size_t)j * 512 * 2048, 2048, 2048, 2}; SchedQlat S{G, bx};
                  epi::EpiBf16<epi::MapQlat> E{epi::MapQlat{QL}}; pg8::gemm_phase(lds, g, S, E); }
            }
            PH_END();
            if (SITE(5) && PH_ON()) for (int rep_ = 0; rep_ < REPS(5); ++rep_) { SITE_LOCALS;
#ifndef ATT_REP
#define ATT_REP 1
#endif
                for (int ra_ = 0; ra_ < ATT_REP; ++ra_) { const att::Tensors T{QN, QR, KN, KR, VV, OB};
                  const int vcu = (G % 8 == 0) ? (bx % 8) * (G / 8) + bx / 8 : bx;
                  for (int id = vcu; id < 512; id += G) { const int bh = id >> 3, x = id & 7;
                      att::attn_block(T, bh >> 4, bh & 15, 15 - x, (char*)lds_raw); att::attn_block(T, bh >> 4, bh & 15, x, (char*)lds_raw); } }
                { pg8::Gemm g{QL, KCj, QLD, QLD, 10}; SchedScores S{G, bx}; epi::EpiScoresExp E{PP, WSP(float, WS_LP), (unsigned*)(ws + WS_CTL) + CW_SMFLAG + j}; pg8::gemm_phase(lds, g, S, E); }
            }
            PH_END();
            { bool exact_; { SITE_LOCALS; exact_ = use_bar && PH_ON() && __builtin_amdgcn_readfirstlane(__hip_atomic_load((unsigned*)(ws + WS_CTL) + CW_SMFLAG + j, __ATOMIC_RELAXED, __HIP_MEMORY_SCOPE_AGENT)) != 0u; }
              if (exact_) {
                { SITE_LOCALS; pg8::Gemm g{QL, KCj, QLD, QLD, 10}; SchedScores S{G, bx}; epi::EpiBf16<epi::MapScores> E{epi::MapScores{WSP(bf16_t, WS_S)}}; pg8::gemm_phase(lds, g, S, E); }
                xcd_barrier(bar);
                { SITE_LOCALS; CTX_LOCALS; thin::softmax_rows(C, WSP(bf16_t, WS_S), PP); }
                xcd_barrier(bar);
              }
              if (SITE(6) && PH_ON()) { SITE_LOCALS; CTX_LOCALS; thin::rowsum_inv(C, WSP(float, WS_LP), WSP(float, WS_IL), exact_); }
            }
            if (SITE(7) && PH_ON()) for (int rep_ = 0; rep_ < REPS(7); ++rep_) { SITE_LOCALS; pg8::Gemm g{PP, KCj, KEYP, QLD, 66};     SchedPV S{G, bx}; epi::EpiBf16NP<epi::MapPV> E{epi::MapPV{OL}}; pg8::gemm_phase<epi::EpiBf16NP<epi::MapPV>, SchedPV, true>(lds, g, S, E);
                { pg8::Gemm g2{OB, W6 + (size_t)j * 2048 * 2048, 2048, 2048, 32}; SchedEarlyMix S2; S2.init(G, bx); epi::EpiResid E2{XB, ssq_ffn, WSP(float, WS_SLAB)}; pg8::gemm_phase(lds, g2, S2, E2); } }
            PH_END();
            if (SITE(8) && PH_ON()) for (int rep_ = 0; rep_ < REPS(8); ++rep_) { SITE_LOCALS; pg8::Gemm g{OL, W5 + (size_t)j * 2048 * 1024, 8192, 1024, 16}; SchedO2 S{G, bx}; epi::EpiO2 E{OB, WSP(float, WS_IL)}; pg8::gemm_phase(lds, g, S, E); }
            PH_END();
        } else {
            if (SITE(9) && PH_ON()) for (int rep_ = 0; rep_ < REPS(9); ++rep_) { SITE_LOCALS;
                pg8::Gemm g{XB, W9 + (size_t)j * 6144 * 2048, 2048, 2048, 32}; pg8::SchedMN S; S.init(MT / 256, 24, G, bx, (size_t)256 * 2048 * 2, (size_t)256 * 2048 * 2);
                epi::EpiWin E{ssq_mix, GB, UU, out + O_CONVP + (size_t)j * NB * 2 * DM, out + O_CONVS + (size_t)j * DB * 2 * DM};
                pg8::gemm_phase(lds, g, S, E);
            }
            PH_END();
            if (SITE(10) && PH_ON()) for (int rep_ = 0; rep_ < REPS(10); ++rep_) { SITE_LOCALS; CTX_LOCALS; thin::conv_pass(C, GB, UU, args.conv_w + (size_t)j * 3 * DM, args.state_conv + (size_t)j * DB * 2 * DM, OB); }
            PH_END();
        }
        if (SITE(11) && PH_ON()) for (int rep_ = 0; rep_ < REPS(11); ++rep_) { SITE_LOCALS;
            pg8::Gemm g{OB, ((i & 1) == 0 ? W6 : W10) + (size_t)j * 2048 * 2048, 2048, 2048, 32}; SchedResid S; S.init(G, bx, 2048, 2048, 32, false, (i & 1) == 0 ? 256 : 0);
            epi::EpiResid E{XB, ssq_ffn, WSP(float, WS_SLAB)};
            pg8::gemm_phase(lds, g, S, E);
        }
        PH_END();
        if (SITE(15) && PH_ON()) { SITE_LOCALS; CTX_LOCALS; thin::resid_finalize(C, WSP(float, WS_SLAB), XB, ssq_ffn); }
        PH_END();
        if (SITE(12) && PH_ON()) for (int rep_ = 0; rep_ < REPS(12); ++rep_) { SITE_LOCALS;
            pg8::Gemm g{XB, W7 + (size_t)i * 8192 * 2048, 2048, 2048, 32}; pg8::SchedMN S; S.init(MT / 256, 32, G, bx, (size_t)256 * 2048 * 2, (size_t)256 * 2048 * 2);
            epi::EpiFF1 E{ssq_ffn, HB}; pg8::gemm_phase(lds, g, S, E);
        }
        PH_END();
        if (SITE(13) && PH_ON()) for (int rep_ = 0; rep_ < REPS(13); ++rep_) { SITE_LOCALS;
            pg8::Gemm g{HB, W8 + (size_t)i * 2048 * 8192, 8192, 8192, 128}; SchedResid S; S.init(G, bx, 8192, 8192, 128, true);
            epi::EpiResid E{XB, ssq_next, WSP(float, WS_SLAB)}; pg8::gemm_phase(lds, g, S, E);
        }
        PH_END();
        if (SITE(16) && PH_ON()) { SITE_LOCALS; CTX_LOCALS; thin::resid_finalize(C, WSP(float, WS_SLAB), XB, ssq_next); }
        PH_END();
    }
    if (SITE(14) && PH_ON()) for (int rep_ = 0; rep_ < REPS(14); ++rep_) { SITE_LOCALS; CTX_LOCALS; thin::final_norm(C, XB, SSQ + (size_t)8 * MT * 32, args.norm_final, out + O_YP, out + O_YS); }
    PH_END();
#undef PH_ON
#undef PH_END
}

#ifndef MEMSET_BYTES
#define MEMSET_BYTES CTL_BYTES
#endif
extern "C" void kernel_launch(void* const* d_in, const int* in_sizes, int n_in, void* d_out, int out_size, void* d_ws, size_t ws_size, hipStream_t stream) {
    static int grid = 0;
    if (grid == 0) {
        if (n_in != 21 || (size_t)out_size != O_END || ws_size < WS_END) { fprintf(stderr, "kernel_launch: unexpected shapes (n_in %d, out %d, ws %zu; need 21, %zu, >= %zu); nothing launched\n", n_in, out_size, ws_size, (size_t)O_END, (size_t)WS_END); grid = -1; return; }
        int dev = 0, cus = 0, per_cu = 0;
        if (hipGetDevice(&dev) != hipSuccess || hipDeviceGetAttribute(&cus, hipDeviceAttributeMultiprocessorCount, dev) != hipSuccess) { fprintf(stderr, "kernel_launch: device query failed\n"); grid = -1; return; }
        if (hipFuncSetAttribute((const void*)mk_fwd, hipFuncAttributeMaxDynamicSharedMemorySize, LDS_BYTES) != hipSuccess) { fprintf(stderr, "kernel_launch: hipFuncSetAttribute failed\n"); grid = -1; return; }
        if (hipOccupancyMaxActiveBlocksPerMultiprocessor(&per_cu, (const void*)mk_fwd, NWAVES * 64, LDS_BYTES) != hipSuccess || per_cu < 1) { fprintf(stderr, "kernel_launch: occupancy query reports %d workgroups per CU\n", per_cu); per_cu = 1; }
        (void)hipGetLastError();
        grid = cus;
    }
    if (grid < 0) return;
    (void)hipMemsetAsync((char*)d_ws + WS_CTL, 0, (size_t)MEMSET_BYTES, stream);
    Args a{};
    const float** pa = (const float**)&a;
    for (int i = 0; i < 21; ++i) pa[i] = (const float*)d_in[i];
    a.out = (float*)d_out; a.ws = (unsigned char*)d_ws;
#ifndef MK_CHECK
    a.ph_lo = 0; a.ph_hi = N_PHASES;
    hipLaunchKernelGGL(mk_fwd, dim3(grid), dim3(NWAVES * 64), LDS_BYTES, stream, a);
#else
    MK_CHECK_BODY
#endif
}
```

```cpp
#include <hip/hip_runtime.h>
#include <hip/hip_bf16.h>
#include <cstdio>
#include <cstdint>

#define LAS __attribute__((address_space(3)))
#define GAS __attribute__((address_space(1)))
typedef unsigned short bf16_t;
typedef short bf16x8 __attribute__((ext_vector_type(8)));
typedef short s16x4 __attribute__((ext_vector_type(4)));
typedef float f32x2 __attribute__((ext_vector_type(2)));
typedef float f32x4 __attribute__((ext_vector_type(4)));
typedef float f32x16 __attribute__((ext_vector_type(16)));
typedef unsigned u32x2 __attribute__((ext_vector_type(2)));
typedef unsigned u32x4 __attribute__((ext_vector_type(4)));

constexpr int DM = 2048, NB = 4, SEQ = 4096, DEPTH = 4, DB = 32, DS = 32, PAST = 4096;
constexpr int NH = 16, QKN = 128, QKR = 64, VH = 128, QL_ = 512, KVL = 512, DFF = 8192;
constexpr int MP = NB * SEQ;
constexpr int MS = DB * DS;
constexpr int MT = MP + MS;
constexpr int NKEY = PAST + DS;
constexpr int KEYP = 4352;
constexpr int QLD = 640;
constexpr float EPS = 1e-6f;
constexpr float QSCALE = 0.07216878364870322f * 1.4426950408889634f;
constexpr int NPOS = NKEY;

constexpr size_t O_YP = 0;
constexpr size_t O_YS = O_YP + (size_t)MP * DM;
constexpr size_t O_CKVP = O_YS + (size_t)MS * DM;
constexpr size_t O_KRP = O_CKVP + (size_t)2 * MP * KVL;
constexpr size_t O_CONVP = O_KRP + (size_t)2 * MP * QKR;
constexpr size_t O_CKVS = O_CONVP + (size_t)2 * NB * 2 * DM;
constexpr size_t O_KRS = O_CKVS + (size_t)2 * MS * KVL;
constexpr size_t O_CONVS = O_KRS + (size_t)2 * MS * QKR;
constexpr size_t O_END = O_CONVS + (size_t)2 * DB * 2 * DM;
static_assert(O_END == 56000512ull, "d_out size");

constexpr size_t al256(size_t x) { return (x + 255) & ~(size_t)255; }
constexpr size_t WS_CTL = 0, CTL_BYTES = 1u << 20;
constexpr size_t WS_CS = WS_CTL + CTL_BYTES;
constexpr size_t WS_SSQ = al256(WS_CS + (size_t)NPOS * 64 * 4);
constexpr size_t SSQ_ONE = (size_t)MT * 32 * 4;
constexpr size_t WS_SSQCQ = WS_SSQ + 9 * SSQ_ONE;
constexpr size_t WS_SSQKV = WS_SSQCQ + (size_t)MT * 8 * 4;
constexpr size_t WS_X = al256(WS_SSQKV + (size_t)MT * 8 * 4);
constexpr size_t WS_XB = WS_X + (size_t)MT * DM * 4;
constexpr size_t WS_CQ = WS_XB + (size_t)MT * DM * 2;
constexpr size_t WS_KVRAW = WS_CQ + (size_t)MT * 512 * 2;
constexpr size_t WS_CKV = WS_KVRAW + (size_t)MT * 512 * 4;
constexpr size_t WS_KR = WS_CKV + (size_t)MP * 512 * 2;
constexpr size_t WS_QN = WS_KR + (size_t)MP * 64 * 2;
constexpr size_t WS_SLAB = WS_QN;
static_assert((size_t)8 * MS * DM * 4 <= (size_t)MT * 2048 * 2, "slabs fit QN");
constexpr size_t WS_QR = WS_QN + (size_t)MT * 2048 * 2;
constexpr size_t WS_KN = WS_QR + (size_t)MP * 1024 * 2;
constexpr size_t WS_V = WS_KN + (size_t)MT * 2048 * 2;
constexpr size_t WS_GB = WS_KN, WS_U = WS_V;
constexpr size_t WS_O = WS_V + (size_t)MT * 2048 * 2;
constexpr size_t WS_QL = WS_O + (size_t)MT * 2048 * 2;
constexpr size_t WS_OL = WS_QL + (size_t)MS * 16 * QLD * 2;
constexpr size_t WS_KC = WS_OL + (size_t)MS * 16 * 512 * 2;
constexpr size_t KC_ONE = (size_t)DB * KEYP * QLD * 2;
constexpr size_t WS_VT = WS_KC + 2 * KC_ONE;
constexpr size_t WS_LP = WS_VT;
constexpr int LPP = 72;
constexpr size_t WS_IL = WS_LP + (size_t)DB * 512 * LPP * 4;
constexpr size_t VT_ONE = (size_t)DB * 512 * KEYP * 2;
constexpr size_t WS_S = WS_VT + 2 * VT_ONE;
constexpr size_t WS_HB = WS_S;
constexpr size_t S_BYTES = (size_t)DB * 512 * KEYP * 4;
static_assert(S_BYTES >= (size_t)MT * DFF * 2, "HB overlays S");
constexpr size_t WS_P = WS_S + S_BYTES;
constexpr size_t WS_W1 = WS_P + (size_t)DB * 512 * KEYP * 2;
constexpr size_t WS_W2 = WS_W1 + (size_t)2 * 1280 * 2048 * 2;
constexpr size_t WS_W3 = WS_W2 + (size_t)2 * 3072 * 512 * 2;
constexpr size_t WS_WUK = WS_W3 + (size_t)2 * 4096 * 512 * 2;
constexpr size_t WS_W5 = WS_WUK + (size_t)2 * 512 * 2048 * 2;
constexpr size_t WS_W6 = WS_W5 + (size_t)2 * 8 * 256 * 1024 * 2;
constexpr size_t WS_W10 = WS_W6 + (size_t)2 * 2048 * 2048 * 2;
constexpr size_t WS_W9 = WS_W10 + (size_t)2 * 2048 * 2048 * 2;
constexpr size_t WS_W7 = WS_W9 + (size_t)2 * 6144 * 2048 * 2;
constexpr size_t WS_W8 = WS_W7 + (size_t)4 * 8192 * 2048 * 2;
constexpr size_t WS_END = WS_W8 + (size_t)4 * 2048 * 8192 * 2;
static_assert(WS_END <= 2147483648ull, "workspace map must fit 4 x largest tensor");

constexpr int CW_BAR = 4096, CW_SMFLAG = 12288;

__device__ __forceinline__ unsigned cvt_pk_bf16(float lo, float hi) { unsigned r; asm volatile("v_cvt_pk_bf16_f32 %0, %1, %2" : "=v"(r) : "v"(lo), "v"(hi)); return r; }
__device__ __forceinline__ float bf2f(unsigned short b) { return __uint_as_float((unsigned)b << 16); }
__device__ __forceinline__ float wave_sum(float v) {
#pragma unroll
    for (int o = 1; o < 64; o <<= 1) v += __shfl_xor(v, o);
    return v;
}
__device__ __forceinline__ float wave_max(float v) {
#pragma unroll
    for (int o = 1; o < 64; o <<= 1) v = fmaxf(v, __shfl_xor(v, o));
    return v;
}
#define LDS_WAIT() asm volatile("s_waitcnt lgkmcnt(0)" ::: "memory")
#define VM_WAIT() asm volatile("s_waitcnt vmcnt(0)" ::: "memory")

namespace pg8 {
constexpr int BM = 256, BK = 64, HALF = 128, HTB = HALF * BK * 2, STAGE_BYTES = 8 * HTB, NXCD = 8, WGM = 8;
__host__ __device__ __forceinline__ int lds_byte(int r, int c) { const int st = (r >> 4) * 2 + (c >> 5), rr = r & 15, cc = c & 31, ob = rr * 64 + cc * 2; return st * 1024 + (ob ^ (((ob >> 9) & 1) << 5)); }
__host__ __device__ __forceinline__ void stage_rc(int b, int& R, int& C) { const int st = b / 1024, sb = b % 1024, swz = sb ^ (((sb >> 9) & 1) << 5); R = (st >> 1) * 16 + swz / 64; C = (st & 1) * 32 + (swz % 64) / 2; }
__host__ __device__ __forceinline__ int perm32(int rho) { const int n = rho >> 4, i = rho & 15; return 8 * (i >> 2) + 4 * n + (i & 3); }

struct Unit { int pm, pn, z; };
struct Gemm { const bf16_t* A; const bf16_t* Bt; int lda, ldb, nt; };

struct SchedMN {
    int nM, nN, nwg, G, c, wgm, pnoff; size_t astep, bstep;
    __device__ __forceinline__ void init(int nM_, int nN_, int G_, int c_, size_t astep_, size_t bstep_, int wgm_ = WGM, int pnoff_ = 0) { nM = nM_; nN = nN_; nwg = nM * nN; G = G_; c = c_; astep = astep_; bstep = bstep_; wgm = wgm_; pnoff = pnoff_; }
    __device__ __forceinline__ bool next(int i, Unit& u, size_t& aoff, size_t& boff, int& unt) const { return map((long)i * G + c, u, aoff, boff); }
    __device__ __forceinline__ bool map(const long L, Unit& u, size_t& aoff, size_t& boff) const {
        if (L >= nwg) return false;
        int wgid = (int)L; { const int q = nwg / NXCD, r = nwg % NXCD, xcd = wgid % NXCD, off = wgid / NXCD; wgid = (xcd < r ? xcd * (q + 1) : r * (q + 1) + (xcd - r) * q) + off; }
        const int nig = wgm * nN, gid = wgid / nig, fm = gid * wgm, gsz = (nM - fm) < wgm ? (nM - fm) : wgm;
        u.pm = fm + ((wgid % nig) % gsz); u.pn = (wgid % nig) / gsz + pnoff; u.z = 0;
        aoff = (size_t)u.pm * astep; boff = (size_t)u.pn * bstep; return true;
    }
};

template <class Epi, class Sched, bool BTR = false>
__device__ __forceinline__ void gemm_phase(LAS unsigned char* lds, const Gemm g, const Sched& S, const Epi& E) {
    int tid = threadIdx.x; asm volatile("" : "+v"(tid));
    const int wid = __builtin_amdgcn_readfirstlane(tid >> 6), lane = tid & 63, wr = wid >> 2, wc = wid & 3, fr = lane & 15, fq = lane >> 4;
    int nt = g.nt; asm volatile("" : "+s"(nt));
    int nnt = nt;
    unsigned voffA[2], voffB[2];
#pragma unroll
    for (int i = 0; i < 2; ++i) { int R, C; stage_rc(tid * 16 + i * 8192, R, C); const int Rb = Epi::PERM ? ((R & ~31) + perm32(R & 31)) : R;
        voffA[i] = (unsigned)(R * g.lda + C) * 2u; voffB[i] = (unsigned)(Rb * g.ldb + C) * 2u;
        if constexpr (BTR) { const unsigned sb = (unsigned)(tid * 16 + i * 8192), row = sb >> 8, ch = ((sb >> 4) & 15u) ^ (((row & 3u) << 2) | ((row >> 2) & 3u));
            voffB[i] = (row * (unsigned)g.ldb + ch * 8u) * 2u; } }
    const size_t hstepA = (size_t)HALF * g.lda * 2, hstepB = BTR ? (size_t)HALF * 2 : (size_t)HALF * g.ldb * 2;
    const long kmulB = BTR ? (long)g.ldb : 1L;
    unsigned trb[2][2];
    if constexpr (BTR) {
#pragma unroll
        for (int n = 0; n < 2; ++n)
#pragma unroll
            for (int t = 0; t < 2; ++t) { const unsigned q = (unsigned)(lane & 15) >> 2, p = (unsigned)lane & 3u, row = 8u * (unsigned)fq + 4u * t + q, ch = 2u * (unsigned)(wc * 2 + n) + (p >> 1);
                trb[n][t] = (unsigned)(size_t)lds + 4u * HTB + 256u * row + 16u * (ch ^ (((row & 3u) << 2) | ((row >> 2) & 3u))) + 8u * (p & 1u); } }
    const unsigned ldsw = (unsigned)wid * 1024u;
    const int aoff = lds_byte(wr * 64 + fr, fq * 8), boff = lds_byte(wc * 32 + fr, fq * 8);
#define PG8_SA(b, h) (((b) * 2 + (h)) * HTB)
#define PG8_SB(b, h) ((4 + (b) * 2 + (h)) * HTB)
#define PG8_STAGE(bufoff, gbase, voff) do { _Pragma("unroll") for (int _i = 0; _i < 2; ++_i) \
        __builtin_amdgcn_global_load_lds((const unsigned*)((const char*)(gbase) + (voff)[_i]), (LAS unsigned*)(lds + (bufoff) + ldsw + _i * 8192), 16, 0, 0); } while (0)
#define PG8_LDA(dst, b, h) do { _Pragma("unroll") for (int m = 0; m < 4; ++m) _Pragma("unroll") for (int k = 0; k < 2; ++k) dst[m][k] = *(const LAS bf16x8*)(lds + PG8_SA(b, h) + aoff + m * 2048 + k * 1024); } while (0)
#define PG8_LDB(dst, b, h) do { _Pragma("unroll") for (int n = 0; n < 2; ++n) _Pragma("unroll") for (int k = 0; k < 2; ++k) dst[n][k] = *(const LAS bf16x8*)(lds + PG8_SB(b, h) + boff + n * 2048 + k * 1024); } while (0)
#define PG8_TR(dst, addr, off) asm volatile("ds_read_b64_tr_b16 %0, %1 offset:%2" : "=v"(dst) : "v"(addr), "i"(off) : "memory")
#define PG8_LDBT(T, b, h) do { _Pragma("unroll") for (int n = 0; n < 2; ++n) _Pragma("unroll") for (int k = 0; k < 2; ++k) { \
        PG8_TR(T[n][k][0], trb[n][0], ((b) * 2 + (h)) * HTB + k * 8192); PG8_TR(T[n][k][1], trb[n][1], ((b) * 2 + (h)) * HTB + k * 8192); } } while (0)
#define PG8_TIE8(T) "+v"(T[0][0][0]), "+v"(T[0][0][1]), "+v"(T[0][1][0]), "+v"(T[0][1][1]), "+v"(T[1][0][0]), "+v"(T[1][0][1]), "+v"(T[1][1][0]), "+v"(T[1][1][1])
#define PG8_MKB(B, T) do { _Pragma("unroll") for (int n = 0; n < 2; ++n) _Pragma("unroll") for (int k = 0; k < 2; ++k) \
        B[n][k] = (bf16x8){T[n][k][0][0], T[n][k][0][1], T[n][k][0][2], T[n][k][0][3], T[n][k][1][0], T[n][k][1][1], T[n][k][1][2], T[n][k][1][3]}; } while (0)
#define PG8_MMA(ai, bj, At, Bt) do { __builtin_amdgcn_s_setprio(1); _Pragma("unroll") for (int m = 0; m < 4; ++m) _Pragma("unroll") for (int n = 0; n < 2; ++n) _Pragma("unroll") for (int k = 0; k < 2; ++k) \
        acc[ai][bj][m][n] = __builtin_amdgcn_mfma_f32_16x16x32_bf16(Bt[n][k], At[m][k], acc[ai][bj][m][n], 0, 0, 0); __builtin_amdgcn_s_setprio(0); } while (0)
#define PG8_WAIT_V(n) asm volatile("s_waitcnt vmcnt(" #n ")" ::: "memory")
#define PG8_WAIT_L(n) asm volatile("s_waitcnt lgkmcnt(" #n ")" ::: "memory")
#define PG8_BAR __builtin_amdgcn_s_barrier()
#define PG8_SCHED __builtin_amdgcn_sched_barrier(0)
    Unit cur, nxt; int ui = 0; size_t uao, ubo;
    if (!S.next(0, cur, uao, ubo, nt)) return;
    long kstep = nt < 0 ? -(long)(BK * 2) : (long)(BK * 2), nkstep = (long)(BK * 2); if (nt < 0) nt = -nt;
    f32x4 acc[2][2][4][2];
#pragma unroll
    for (int a = 0; a < 2; ++a)
#pragma unroll
        for (int b = 0; b < 2; ++b)
#pragma unroll
            for (int m = 0; m < 4; ++m)
#pragma unroll
                for (int n = 0; n < 2; ++n) acc[a][b][m][n] = (f32x4){0.f, 0.f, 0.f, 0.f};
    bf16x8 At[4][2], B0[2][2], B1[2][2]; s16x4 T0[2][2][2], T1[2][2][2];
    const char* cA = (const char*)g.A + uao; const char* cB = (const char*)g.Bt + ubo;
    PG8_STAGE(PG8_SB(0, 0), cB, voffB); PG8_STAGE(PG8_SB(0, 1), cB + hstepB, voffB); PG8_STAGE(PG8_SA(0, 0), cA, voffA); PG8_STAGE(PG8_SA(0, 1), cA + hstepA, voffA);
    if (wr == 1) PG8_BAR;
    PG8_WAIT_V(2); PG8_BAR;
    PG8_STAGE(PG8_SB(1, 0), cB + kstep * kmulB, voffB); PG8_STAGE(PG8_SA(1, 0), cA + kstep, voffA); PG8_STAGE(PG8_SB(1, 1), cB + hstepB + kstep * kmulB, voffB);
    PG8_WAIT_V(6); PG8_BAR;
    for (;;) {
        const bool has_next = S.next(ui + 1, nxt, uao, ubo, nnt);
        if (has_next) { nkstep = nnt < 0 ? -(long)(BK * 2) : (long)(BK * 2); if (nnt < 0) nnt = -nnt; } else nkstep = kstep;
        const char* nA = has_next ? (const char*)g.A + uao : cA; const char* nB = has_next ? (const char*)g.Bt + ubo : cB;
        for (int t = 0; t < nt; t += 2) {
            const bool last = (t == nt - 2);
            const char* a1 = cA + (long)(t + 1) * kstep;
            const char* a2 = last ? nA : cA + (long)(t + 2) * kstep; const char* b2 = last ? nB : cB + (long)(t + 2) * kstep * kmulB;
            const long ks3 = last ? nkstep : kstep; const char* a3 = a2 + ks3; const char* b3 = b2 + ks3 * kmulB;
            if constexpr (BTR) { PG8_LDBT(T0, 0, 0); PG8_LDBT(T1, 0, 1); } else { PG8_LDB(B0, 0, 0); PG8_LDB(B1, 0, 1); }
            PG8_SCHED; PG8_LDA(At, 0, 0); PG8_STAGE(PG8_SA(1, 1), a1 + hstepA, voffA);
            PG8_WAIT_V(8);
            if constexpr (BTR) { asm volatile("s_waitcnt lgkmcnt(0)" : PG8_TIE8(T0), PG8_TIE8(T1) :: "memory"); PG8_SCHED; PG8_MKB(B0, T0); PG8_MKB(B1, T1); } else PG8_WAIT_L(0);
            PG8_BAR; PG8_MMA(0, 0, At, B0); PG8_MMA(0, 1, At, B1); PG8_BAR; PG8_SCHED;
            PG8_LDA(At, 0, 1); PG8_STAGE(PG8_SB(0, 0), b2, voffB); PG8_STAGE(PG8_SB(0, 1), b2 + hstepB, voffB); PG8_STAGE(PG8_SA(0, 0), a2, voffA);
            PG8_WAIT_V(8); PG8_WAIT_L(0); PG8_BAR; PG8_MMA(1, 0, At, B0); PG8_MMA(1, 1, At, B1); PG8_BAR; PG8_SCHED;
            if constexpr (BTR) { PG8_LDBT(T0, 1, 0); PG8_LDBT(T1, 1, 1); } else { PG8_LDB(B0, 1, 0); PG8_LDB(B1, 1, 1); }
            PG8_SCHED; PG8_LDA(At, 1, 0); PG8_STAGE(PG8_SA(0, 1), a2 + hstepA, voffA);
            PG8_WAIT_V(8);
            if constexpr (BTR) { asm volatile("s_waitcnt lgkmcnt(0)" : PG8_TIE8(T0), PG8_TIE8(T1) :: "memory"); PG8_SCHED; PG8_MKB(B0, T0); PG8_MKB(B1, T1); } else PG8_WAIT_L(0);
            PG8_BAR; PG8_MMA(0, 0, At, B0); PG8_MMA(0, 1, At, B1); PG8_BAR; PG8_SCHED;
            PG8_LDA(At, 1, 1); PG8_STAGE(PG8_SB(1, 0), b3, voffB); PG8_STAGE(PG8_SB(1, 1), b3 + hstepB, voffB); PG8_STAGE(PG8_SA(1, 0), a3, voffA);
            PG8_WAIT_V(8); PG8_WAIT_L(0); PG8_BAR; PG8_MMA(1, 0, At, B0); PG8_MMA(1, 1, At, B1); PG8_BAR; PG8_SCHED;
        }
        if (wr == 0) PG8_BAR;
        E(acc, cur, wr, wc, fr, fq);
        if (!has_next) break;
#pragma unroll
        for (int a = 0; a < 2; ++a)
#pragma unroll
            for (int b = 0; b < 2; ++b)
#pragma unroll
                for (int m = 0; m < 4; ++m)
#pragma unroll
                    for (int n = 0; n < 2; ++n) acc[a][b][m][n] = (f32x4){0.f, 0.f, 0.f, 0.f};
        cur = nxt; cA = nA; cB = nB; ++ui; nt = nnt; kstep = nkstep;
        if (wr == 1) PG8_BAR;
    }
    PG8_WAIT_V(0);
    PG8_BAR;
#undef PG8_SA
#undef PG8_SB
#undef PG8_STAGE
#undef PG8_LDA
#undef PG8_LDB
#undef PG8_TR
#undef PG8_LDBT
#undef PG8_TIE8
#undef PG8_MKB
#undef PG8_MMA
#undef PG8_WAIT_V
#undef PG8_WAIT_L
#undef PG8_BAR
#undef PG8_SCHED
}
}

namespace epi {
using pg8::Unit; using pg8::BM; using pg8::HALF;
typedef f32x4 Acc[2][2][4][2];

template <int NP> __device__ __forceinline__ float row_rstd(const float* part, int row, int fq, float inv_n) {
    float s;
    if constexpr (NP == 32) { const f32x4 a = *(const f32x4*)(part + (size_t)row * 32 + fq * 8), b = *(const f32x4*)(part + (size_t)row * 32 + fq * 8 + 4);
        s = ((a[0] + a[1]) + (a[2] + a[3])) + ((b[0] + b[1]) + (b[2] + b[3])); }
    else { const f32x2 a = *(const f32x2*)(part + (size_t)row * 8 + fq * 2); s = a[0] + a[1]; }
    s += __shfl_xor(s, 16); s += __shfl_xor(s, 32);
    return 1.0f / sqrtf(s * inv_n + EPS);
}
__device__ __forceinline__ float sq4(const f32x4 v) { return (v[0] * v[0] + v[1] * v[1]) + (v[2] * v[2] + v[3] * v[3]); }
__device__ __forceinline__ float sq0(const f32x4 a) { return (a[0] + a[1]) + (a[2] + a[3]); }
__device__ __forceinline__ u32x4 pack8(const f32x4 a, const f32x4 b) { u32x4 w; w.x = cvt_pk_bf16(a[0], a[1]); w.y = cvt_pk_bf16(a[2], a[3]); w.z = cvt_pk_bf16(b[0], b[1]); w.w = cvt_pk_bf16(b[2], b[3]); return w; }
__device__ __forceinline__ f32x4 rope4(const f32x4 v, const f32x4 cs) { return (f32x4){v[0] * cs[0] - v[1] * cs[1], v[0] * cs[1] + v[1] * cs[0], v[2] * cs[2] - v[3] * cs[3], v[2] * cs[3] + v[3] * cs[2]}; }
__device__ __forceinline__ int row_pos(int row) { return row < MP ? (row & (SEQ - 1)) : PAST + ((row - MP) & (DS - 1)); }

struct EpiResid {
    static constexpr bool PERM = true;
    bf16_t* XB; float* ssq; float* slab;
    __device__ __forceinline__ void operator()(const Acc& acc, const Unit& u, int wr, int wc, int fr, int fq) const {
        const int row0 = u.pm * BM + wr * 64 + fr, col0 = u.pn * BM + wc * 32 + 8 * fq;
        if (u.z == 0) {
#pragma unroll
        for (int ai = 0; ai < 2; ++ai)
#pragma unroll
            for (int m = 0; m < 4; ++m) { const int row = row0 + ai * HALF + m * 16;
                bf16_t* xr = XB + (size_t)row * DM + col0;
                float s = 0.f;
#pragma unroll
                for (int bj = 0; bj < 2; ++bj) { const u32x4 xo = *(const u32x4*)(xr + bj * HALF);
                    f32x4 v0 = acc[ai][bj][m][0], v1 = acc[ai][bj][m][1];
                    v0[0] += __uint_as_float(xo.x << 16); v0[1] += __uint_as_float(xo.x & 0xffff0000u); v0[2] += __uint_as_float(xo.y << 16); v0[3] += __uint_as_float(xo.y & 0xffff0000u);
                    v1[0] += __uint_as_float(xo.z << 16); v1[1] += __uint_as_float(xo.z & 0xffff0000u); v1[2] += __uint_as_float(xo.w << 16); v1[3] += __uint_as_float(xo.w & 0xffff0000u);
                    *(u32x4*)(xr + bj * HALF) = pack8(v0, v1); s += sq4(v0) + sq4(v1); }
                s += __shfl_xor(s, 16); s += __shfl_xor(s, 32);
                if (fq == 0) ssq[(size_t)row * 32 + u.pn * 4 + wc] = s; }
        } else {
            bf16_t* sl = (bf16_t*)slab + (size_t)(u.z - 1) * MS * DM;
#pragma unroll
        for (int ai = 0; ai < 2; ++ai)
#pragma unroll
            for (int m = 0; m < 4; ++m) { bf16_t* p = sl + (size_t)(row0 - MP + ai * HALF + m * 16) * DM + col0;
#pragma unroll
                for (int bj = 0; bj < 2; ++bj) *(u32x4*)(p + bj * HALF) = pack8(acc[ai][bj][m][0], acc[ai][bj][m][1]); }
        }
    }
};
struct EpiFF1 {
    static constexpr bool PERM = true;
    const float* ssq; bf16_t* HB;
    __device__ __forceinline__ void operator()(const Acc& acc, const Unit& u, int wr, int wc, int fr, int fq) const {
        const int row0 = u.pm * BM + wr * 64 + fr, col0 = u.pn * BM + wc * 32 + 8 * fq;
#pragma unroll
        for (int ai = 0; ai < 2; ++ai)
#pragma unroll
            for (int m = 0; m < 4; ++m) { const int row = row0 + ai * HALF + m * 16; const float r = row_rstd<32>(ssq, row, fq, 1.0f / DM);
#pragma unroll
                for (int bj = 0; bj < 2; ++bj) { f32x4 v0 = acc[ai][bj][m][0] * r, v1 = acc[ai][bj][m][1] * r;
#pragma unroll
                    for (int e = 0; e < 4; ++e) { const float a = fmaxf(v0[e], 0.f), b = fmaxf(v1[e], 0.f); v0[e] = a * a; v1[e] = b * b; }
                    *(u32x4*)(HB + (size_t)row * DFF + col0 + bj * HALF) = pack8(v0, v1); } }
    }
};
struct EpiW1 {
    static constexpr bool PERM = true;
    const float* ssq; const float* cs; bf16_t* CQ; float* ssqcq; float* KVRAW; float* ssqkv; bf16_t* KR; bf16_t* KC  ; float* okrp; float* okrs  ;
    __device__ __forceinline__ void operator()(const Acc& acc, const Unit& u, int wr, int wc, int fr, int fq) const {
        const int row0 = u.pm * BM + wr * 64 + fr; const int pn = u.pn;
        if (pn == 4 && wc >= 2) return;
#pragma unroll
        for (int ai = 0; ai < 2; ++ai)
#pragma unroll
            for (int m = 0; m < 4; ++m) { const int row = row0 + ai * HALF + m * 16; const float r = row_rstd<32>(ssq, row, fq, 1.0f / DM);
                if (pn < 4) { float s = 0.f; const int cl = (pn & 1) * BM + wc * 32 + 8 * fq;
#pragma unroll
                    for (int bj = 0; bj < 2; ++bj) { const f32x4 v0 = acc[ai][bj][m][0] * r, v1 = acc[ai][bj][m][1] * r; s += sq4(v0) + sq4(v1);
                        if (pn < 2) *(u32x4*)(CQ + (size_t)row * 512 + cl + bj * HALF) = pack8(v0, v1);
                        else *(u32x4*)((bf16_t*)KVRAW + (size_t)row * 512 + cl + bj * HALF) = pack8(v0, v1); }
                    s += __shfl_xor(s, 16); s += __shfl_xor(s, 32);
                    if (fq == 0) { if (pn < 2) ssqcq[(size_t)row * 8 + pn * 4 + wc] = s; else ssqkv[(size_t)row * 8 + (pn - 2) * 4 + wc] = s; } }
                else {
                    const int pos = row_pos(row), p0 = 16 * wc + 4 * fq;
                    const f32x4 c0 = *(const f32x4*)(cs + (size_t)pos * 64 + p0 * 2), c1 = *(const f32x4*)(cs + (size_t)pos * 64 + p0 * 2 + 4);
                    const f32x4 o0 = rope4(acc[ai][0][m][0] * r, c0), o1 = rope4(acc[ai][0][m][1] * r, c1);
                    const u32x4 w = pack8(o0, o1); float* of;
                    if (row < MP) { *(u32x4*)(KR + (size_t)row * 64 + 2 * p0) = w; of = okrp + (size_t)row * 64; }
                    else { const int tok = row - MP, b = tok >> 5, t = tok & 31; *(u32x4*)(KC + ((size_t)b * KEYP + PAST + t) * QLD + 512 + 2 * p0) = w; of = okrs + (size_t)tok * 64; }
                    of[p0] = o0[0]; of[p0 + 32] = o0[1]; of[p0 + 1] = o0[2]; of[p0 + 33] = o0[3];
                    of[p0 + 2] = o1[0]; of[p0 + 34] = o1[1]; of[p0 + 3] = o1[2]; of[p0 + 35] = o1[3]; } }
    }
};
struct EpiW2 {
    static constexpr bool PERM = true;
    const float* ssqcq; const float* cs; bf16_t* QN; bf16_t* QR; bf16_t* QL;
    __device__ __forceinline__ void operator()(const Acc& acc, const Unit& u, int wr, int wc, int fr, int fq) const {
        const int row0 = u.pm * BM + wr * 64 + fr; const int pn = u.pn;
#pragma unroll
        for (int ai = 0; ai < 2; ++ai)
#pragma unroll
            for (int m = 0; m < 4; ++m) { const int row = row0 + ai * HALF + m * 16; const float r = row_rstd<8>(ssqcq, row, fq, 1.0f / 512.0f) * QSCALE;
                if (pn < 8) {
#pragma unroll
                    for (int bj = 0; bj < 2; ++bj) *(u32x4*)(QN + (size_t)row * 2048 + pn * BM + bj * HALF + wc * 32 + 8 * fq) = pack8(acc[ai][bj][m][0] * r, acc[ai][bj][m][1] * r); }
                else { const int pos = row_pos(row), p0 = 16 * (wc & 1) + 4 * fq;
                    const f32x4 c0 = *(const f32x4*)(cs + (size_t)pos * 64 + p0 * 2), c1 = *(const f32x4*)(cs + (size_t)pos * 64 + p0 * 2 + 4);
#pragma unroll
                    for (int bj = 0; bj < 2; ++bj) { const int g = (pn - 8) * BM + bj * HALF + wc * 32;
                        const u32x4 w = pack8(rope4(acc[ai][bj][m][0] * r, c0), rope4(acc[ai][bj][m][1] * r, c1));
                        if (row < MP) *(u32x4*)(QR + (size_t)row * 1024 + g + 8 * fq) = w;
                        else *(u32x4*)(QL + ((size_t)(row - MP) * 16 + (g >> 6)) * QLD + 512 + (g & 63) + 8 * fq) = w; } } }
    }
};
template <class Map> struct EpiBf16 {
    static constexpr bool PERM = true;
    Map map;
    __device__ __forceinline__ void operator()(const Acc& acc, const Unit& u, int wr, int wc, int fr, int fq) const {
#pragma unroll
        for (int ai = 0; ai < 2; ++ai)
#pragma unroll
            for (int m = 0; m < 4; ++m) { bf16_t* p = map(u, ai * HALF + wr * 64 + m * 16 + fr) + wc * 32 + 8 * fq;
#pragma unroll
                for (int bj = 0; bj < 2; ++bj) *(u32x4*)(p + bj * HALF) = pack8(acc[ai][bj][m][0], acc[ai][bj][m][1]); }
    }
};
template <class Map> struct EpiBf16NP {
    static constexpr bool PERM = false;
    Map map;
    __device__ __forceinline__ void operator()(const Acc& acc, const Unit& u, int wr, int wc, int fr, int fq) const {
#pragma unroll
        for (int ai = 0; ai < 2; ++ai)
#pragma unroll
            for (int m = 0; m < 4; ++m) { bf16_t* p = map(u, ai * HALF + wr * 64 + m * 16 + fr) + wc * 32 + 4 * fq;
#pragma unroll
                for (int bj = 0; bj < 2; ++bj)
#pragma unroll
                    for (int n = 0; n < 2; ++n) { const f32x4 v = acc[ai][bj][m][n]; u32x2 w; w.x = cvt_pk_bf16(v[0], v[1]); w.y = cvt_pk_bf16(v[2], v[3]); *(u32x2*)(p + bj * HALF + 16 * n) = w; } }
    }
};
struct MapW3 { bf16_t* KN; bf16_t* V; __device__ __forceinline__ bf16_t* operator()(const Unit& u, int r) const { return (u.pn < 8 ? KN + u.pn * BM : V + (u.pn - 8) * BM) + (size_t)(u.pm * BM + r) * 2048; } };
struct MapQlat { bf16_t* QL; __device__ __forceinline__ bf16_t* operator()(const Unit& u, int r) const { return QL + ((size_t)(u.pm * BM + r) * 16 + u.z) * QLD + u.pn * BM; } };
struct MapPV { bf16_t* OL; __device__ __forceinline__ bf16_t* operator()(const Unit& u, int r) const { return OL + ((size_t)u.z * 512 + u.pm * BM + r) * 512 + u.pn * BM; } };
struct MapO2 { bf16_t* O; __device__ __forceinline__ bf16_t* operator()(const Unit& u, int r) const { return O + (size_t)(MP + u.pm * BM + r) * 2048 + u.pn * BM; } };
struct MapScores { bf16_t* S; __device__ __forceinline__ bf16_t* operator()(const Unit& u, int r) const { return S + ((size_t)u.z * 512 + u.pm * BM + r) * KEYP + u.pn * BM; } };
constexpr float SM_LIM = 96.0f;
struct EpiScoresExp {
    static constexpr bool PERM = true;
    bf16_t* P; float* LP; unsigned* flag;
    __device__ __forceinline__ void operator()(const Acc& acc, const Unit& u, int wr, int wc, int fr, int fq) const {
        const bool tail = (u.pn == 16);
        float amax = 0.f;
#pragma unroll
        for (int ai = 0; ai < 2; ++ai)
#pragma unroll
            for (int m = 0; m < 4; ++m) { const int r = ai * HALF + wr * 64 + m * 16 + fr; const size_t R = (size_t)u.z * 512 + u.pm * BM + r;
                bf16_t* p = P + R * KEYP + u.pn * BM + wc * 32 + 8 * fq; float s = 0.f;
#pragma unroll
                for (int bj = 0; bj < 2; ++bj) { f32x4 v0 = acc[ai][bj][m][0], v1 = acc[ai][bj][m][1];
                    const bool dead = tail && (bj == 1 || wc != 0);
#pragma unroll
                    for (int e = 0; e < 4; ++e) { amax = fmaxf(amax, fmaxf(fabsf(v0[e]), fabsf(v1[e]))); v0[e] = dead ? 0.f : __builtin_amdgcn_exp2f(v0[e]); v1[e] = dead ? 0.f : __builtin_amdgcn_exp2f(v1[e]); }
                    s += sq0(v0) + sq0(v1); *(u32x4*)(p + bj * HALF) = pack8(v0, v1); }
                s += __shfl_xor(s, 16); s += __shfl_xor(s, 32);
                if (fq == 0) LP[R * LPP + u.pn * 4 + wc] = s; }
        if (__any(!(amax <= SM_LIM))) { if (fr == 0 && fq == 0) __hip_atomic_store(flag, 1u, __ATOMIC_RELAXED, __HIP_MEMORY_SCOPE_AGENT); }
    }
};
struct EpiO2 {
    static constexpr bool PERM = true;
    bf16_t* O; const float* IL;
    __device__ __forceinline__ void operator()(const Acc& acc, const Unit& u, int wr, int wc, int fr, int fq) const {
#pragma unroll
        for (int ai = 0; ai < 2; ++ai)
#pragma unroll
            for (int m = 0; m < 4; ++m) { const int tok = u.pm * BM + ai * HALF + wr * 64 + m * 16 + fr; bf16_t* p = O + (size_t)(MP + tok) * 2048 + u.pn * BM + wc * 32 + 8 * fq;
#pragma unroll
                for (int bj = 0; bj < 2; ++bj) { const float il = IL[(size_t)tok * 16 + u.pn * 2 + bj]; *(u32x4*)(p + bj * HALF) = pack8(acc[ai][bj][m][0] * il, acc[ai][bj][m][1] * il); } }
    }
};
struct EpiWin {
    static constexpr bool PERM = true;
    const float* ssq; bf16_t* GB; bf16_t* U; float* ocp; float* ocs  ;
    __device__ __forceinline__ void operator()(const Acc& acc, const Unit& u, int wr, int wc, int fr, int fq) const {
        const int row0 = u.pm * BM + wr * 64 + fr; const int pn = u.pn;
#pragma unroll
        for (int ai = 0; ai < 2; ++ai)
#pragma unroll
            for (int m = 0; m < 4; ++m) { const int row = row0 + ai * HALF + m * 16; const float r = row_rstd<32>(ssq, row, fq, 1.0f / DM);
                if (pn < 8) {
#pragma unroll
                    for (int bj = 0; bj < 2; ++bj) *(u32x4*)(GB + (size_t)row * DM + pn * BM + bj * HALF + wc * 32 + 8 * fq) = pack8(acc[ai][bj][m][0] * r, acc[ai][bj][m][1] * r); }
                else { const float r2 = r * r; const int c = (pn - 8) * HALF + wc * 32 + 8 * fq;
                    const f32x4 u0 = acc[ai][0][m][0] * acc[ai][1][m][0] * r2, u1 = acc[ai][0][m][1] * acc[ai][1][m][1] * r2;
                    *(u32x4*)(U + (size_t)row * DM + c) = pack8(u0, u1);
                    float* of = nullptr;
                    if (row < MP) { const int t = row & (SEQ - 1); if (t >= SEQ - 2) of = ocp + ((size_t)(row >> 12) * 2 + (t - (SEQ - 2))) * DM; }
                    else { const int tok = row - MP, t = tok & 31; if (t >= DS - 2) of = ocs + ((size_t)(tok >> 5) * 2 + (t - (DS - 2))) * DM; }
                    if (of) { *(f32x4*)(of + c) = u0; *(f32x4*)(of + c + 4) = u1; } } }
    }
};
struct EpiGateConv {
    static constexpr bool PERM = true;
    const float* ssq; const bf16_t* U; const float* cw  ; const float* st  ; bf16_t* A2;
    __device__ __forceinline__ static void up8(const u32x4 w, float (&f)[8]) {
#pragma unroll
        for (int e = 0; e < 4; ++e) { f[2 * e] = __uint_as_float(w[e] << 16); f[2 * e + 1] = __uint_as_float(w[e] & 0xffff0000u); } }
    __device__ __forceinline__ void operator()(const Acc& acc, const Unit& u, int wr, int wc, int fr, int fq) const {
        const int row0 = u.pm * BM + wr * 64 + fr;
        float rr[8];
#pragma unroll
        for (int ai = 0; ai < 2; ++ai)
#pragma unroll
            for (int m = 0; m < 4; ++m) rr[ai * 4 + m] = row_rstd<32>(ssq, row0 + ai * HALF + m * 16, fq, 1.0f / DM);
#pragma unroll
        for (int bj = 0; bj < 2; ++bj) { const int c = u.pn * BM + bj * HALF + wc * 32 + 8 * fq;
            float w0[8], w1[8], w2[8];
            { const f32x4 a = *(const f32x4*)(cw + c), b = *(const f32x4*)(cw + c + 4), d = *(const f32x4*)(cw + DM + c), e = *(const f32x4*)(cw + DM + c + 4), f = *(const f32x4*)(cw + 2 * DM + c), g = *(const f32x4*)(cw + 2 * DM + c + 4);
#pragma unroll
              for (int k = 0; k < 4; ++k) { w0[k] = a[k]; w0[4 + k] = b[k]; w1[k] = d[k]; w1[4 + k] = e[k]; w2[k] = f[k]; w2[4 + k] = g[k]; } }
#pragma unroll
            for (int ai = 0; ai < 2; ++ai)
#pragma unroll
                for (int m = 0; m < 4; ++m) { const int row = row0 + ai * HALF + m * 16; const float r = rr[ai * 4 + m];
                    float u0[8], u1[8], u2[8];
                    up8(*(const u32x4*)(U + (size_t)row * DM + c), u2);
                    int t; const float* s0 = nullptr;
                    if (row < MP) t = row & (SEQ - 1); else { const int tok = row - MP; t = tok & 31; s0 = st + (size_t)(tok >> 5) * 2 * DM + c; }
                    if (t >= 1) up8(*(const u32x4*)(U + (size_t)(row - 1) * DM + c), u1);
                    else if (s0) { const f32x4 a = *(const f32x4*)(s0 + DM), b = *(const f32x4*)(s0 + DM + 4);
#pragma unroll
                        for (int e = 0; e < 4; ++e) { u1[e] = a[e]; u1[4 + e] = b[e]; } }
                    else {
#pragma unroll
                        for (int e = 0; e < 8; ++e) u1[e] = 0.f; }
                    if (t >= 2) up8(*(const u32x4*)(U + (size_t)(row - 2) * DM + c), u0);
                    else if (s0) { const float* h = s0 + (size_t)t * DM; const f32x4 a = *(const f32x4*)(h), b = *(const f32x4*)(h + 4);
#pragma unroll
                        for (int e = 0; e < 4; ++e) { u0[e] = a[e]; u0[4 + e] = b[e]; } }
                    else {
#pragma unroll
                        for (int e = 0; e < 8; ++e) u0[e] = 0.f; }
                    const f32x4 g0 = acc[ai][bj][m][0] * r, g1 = acc[ai][bj][m][1] * r; f32x4 o0, o1;
#pragma unroll
                    for (int e = 0; e < 4; ++e) { o0[e] = g0[e] * (w0[e] * u0[e] + w1[e] * u1[e] + w2[e] * u2[e]); o1[e] = g1[e] * (w0[4 + e] * u0[4 + e] + w1[4 + e] * u1[4 + e] + w2[4 + e] * u2[4 + e]); }
                    *(u32x4*)(A2 + (size_t)row * DM + c) = pack8(o0, o1); } }
    }
};
}

namespace att {
constexpr int NW = 8, QBLK = 32, KVBLK = 64, QB = NW * QBLK, D = 128;
constexpr int SHM_V = KVBLK * D * 2, SHM_K = KVBLK * D * 2, SHM_R = KVBLK * 64 * 2;
constexpr int OFF_V = 0, OFF_K = 2 * SHM_V, OFF_R = OFF_K + 2 * SHM_K, OFF_WS = OFF_R + 2 * SHM_R, OFF_QR = OFF_WS + NW * 64 * 4, LDS_BYTES = OFF_QR + NW * 4096;
constexpr float THR2 = 11.0f;
#define KSWZ(row, colB) ((row) * 256 + ((colB) ^ (((row) & 7) << 4)))
#define RSWZ(row, colB) ((row) * 128 + ((colB) ^ (((row) & 7) << 4)))
#define SBAR() __builtin_amdgcn_sched_barrier(0)
__device__ __forceinline__ int v_st(int k, int c) { const int kk = (k & ~0xC) | ((k & 4) << 1) | ((k & 8) >> 1); return ((kk >> 3) * 4 + (c >> 5)) * 512 + ((kk & 7) * 32 + (c & 31)) * 2; }
__device__ __forceinline__ int v_rd_base(int lane) { return ((lane & 3) << 3) | (((lane >> 2) & 3) << 6) | (((lane >> 4) & 1) << 5) | (((lane >> 5) & 1) << 8); }
constexpr int v_rd_off(int d0, int ks, int half) { return d0 * 512 + ks * 4096 + half * 2048; }
__device__ __forceinline__ int crow(int r, int hi) { return (r & 3) + 8 * (r >> 2) + 4 * hi; }

__device__ __forceinline__ void partialSM(f32x16& p0, f32x16& p1, float& m_reg, float& mn, float& alpha) {
    float pmax = p0[0];
#pragma unroll
    for (int r = 1; r < 16; ++r) pmax = fmaxf(pmax, p0[r]);
#pragma unroll
    for (int r = 0; r < 16; ++r) pmax = fmaxf(pmax, p1[r]);
    { auto rr = __builtin_amdgcn_permlane32_swap(__float_as_uint(pmax), __float_as_uint(pmax), false, false);
      pmax = fmaxf(__uint_as_float(rr[0]), __uint_as_float(rr[1])); }
    if (__builtin_expect(__all((pmax - m_reg) <= THR2), 1)) { mn = m_reg; alpha = 1.f; }
    else { mn = fmaxf(m_reg, pmax); alpha = __builtin_amdgcn_exp2f(m_reg - mn); m_reg = mn; }
#pragma unroll
    for (int r = 0; r < 16; ++r) p0[r] = p0[r] - mn;
#pragma unroll
    for (int r = 0; r < 16; ++r) p1[r] = p1[r] - mn;
#pragma unroll
    for (int r = 0; r < 16; ++r) p0[r] = __builtin_amdgcn_exp2f(p0[r]);
}
__device__ __forceinline__ void partialSM2(f32x16& p0, f32x16& p1, float& m_reg, float& alpha) {
    float pmax = p0[0];
#pragma unroll
    for (int r = 1; r < 16; ++r) pmax = fmaxf(pmax, p0[r]);
#pragma unroll
    for (int r = 0; r < 16; ++r) pmax = fmaxf(pmax, p1[r]);
    { auto rr = __builtin_amdgcn_permlane32_swap(__float_as_uint(pmax), __float_as_uint(pmax), false, false);
      pmax = fmaxf(__uint_as_float(rr[0]), __uint_as_float(rr[1])); }
    if (__builtin_expect(__all(pmax <= THR2), 1)) { alpha = 1.f; }
    else { const float d = fmaxf(pmax, 0.f); alpha = __builtin_amdgcn_exp2f(-d); m_reg += d;
#pragma unroll
        for (int r = 0; r < 16; ++r) { p0[r] -= d; p1[r] -= d; } }
#pragma unroll
    for (int r = 0; r < 16; ++r) p0[r] = __builtin_amdgcn_exp2f(p0[r]);
}
__device__ __forceinline__ void finishSM(f32x16& p0, f32x16& p1, float alpha, float& l_reg, bf16x8& pa0, bf16x8& pa1, bf16x8& pa2, bf16x8& pa3) {
#pragma unroll
    for (int r = 0; r < 16; ++r) p1[r] = __builtin_amdgcn_exp2f(p1[r]);
    float ps = 0;
#pragma unroll
    for (int r = 0; r < 16; ++r) ps += p0[r];
#pragma unroll
    for (int r = 0; r < 16; ++r) ps += p1[r];
    { auto rr = __builtin_amdgcn_permlane32_swap(__float_as_uint(ps), __float_as_uint(ps), false, false);
      ps = __uint_as_float(rr[0]) + __uint_as_float(rr[1]); }
    l_reg = l_reg * alpha + ps;
#define PK4(P, B_, OUT) do { unsigned a0 = cvt_pk_bf16(P[B_+0], P[B_+1]), a1 = cvt_pk_bf16(P[B_+2], P[B_+3]);                          \
        unsigned b0 = cvt_pk_bf16(P[B_+4], P[B_+5]), b1 = cvt_pk_bf16(P[B_+6], P[B_+7]);                                             \
        auto r0 = __builtin_amdgcn_permlane32_swap(a0, b0, false, false); auto r1 = __builtin_amdgcn_permlane32_swap(a1, b1, false, false); \
        u32x4 w = {r0[0], r1[0], r0[1], r1[1]}; OUT = *reinterpret_cast<bf16x8*>(&w); } while (0)
    PK4(p0, 0, pa0); PK4(p0, 8, pa1); PK4(p1, 0, pa2); PK4(p1, 8, pa3);
#undef PK4
}
template <int KB>
__device__ __forceinline__ void qkt(f32x16& p0, f32x16& p1, const char* lds, int r32, int hi, const bf16x8* qr, const char* qrl, bool act, float cinit) {
    if (!act) { const float NEG = -__builtin_inff();
#pragma unroll
        for (int r = 0; r < 16; ++r) { p0[r] = NEG; p1[r] = NEG; } return; }
#pragma unroll
    for (int r = 0; r < 16; ++r) { p0[r] = cinit; p1[r] = cinit; }
    const char* kb[4];
#pragma unroll
    for (int dd = 0; dd < 4; ++dd) kb[dd] = lds + OFF_K + KB * SHM_K + KSWZ(r32, (dd * 16 + hi * 8) * 2);
#pragma unroll
    for (int d0 = 0; d0 < 8; ++d0) { const char* a = kb[d0 & 3] + (d0 >> 2) * 128;
        bf16x8 b0 = *reinterpret_cast<const bf16x8*>(a);
        bf16x8 b1 = *reinterpret_cast<const bf16x8*>(a + 32 * 256);
        p0 = __builtin_amdgcn_mfma_f32_32x32x16_bf16(b0, qr[d0], p0, 0, 0, 0);
        p1 = __builtin_amdgcn_mfma_f32_32x32x16_bf16(b1, qr[d0], p1, 0, 0, 0); }
#pragma unroll
    for (int dd = 0; dd < 4; ++dd) { const char* a = lds + OFF_R + KB * SHM_R + RSWZ(r32, (dd * 16 + hi * 8) * 2);
        bf16x8 b0 = *reinterpret_cast<const bf16x8*>(a);
        bf16x8 b1 = *reinterpret_cast<const bf16x8*>(a + 32 * 128);
        const bf16x8 qf = *reinterpret_cast<const bf16x8*>(qrl + dd * 1024);
        p0 = __builtin_amdgcn_mfma_f32_32x32x16_bf16(b0, qf, p0, 0, 0, 0);
        p1 = __builtin_amdgcn_mfma_f32_32x32x16_bf16(b1, qf, p1, 0, 0, 0); }
}
template <int VB>
__device__ __forceinline__ void pv_tile(f32x16* o, int vb0, bf16x8 pa0, bf16x8 pa1, bf16x8 pa2, bf16x8 pa3, bool act) {
    if (!act) return;
#define TRRD(dst, off) asm volatile("ds_read_b64_tr_b16 %0, %1 offset:%2" : "=&v"(dst) : "v"(vb0), "i"(off) : "memory")
#define PV_D0(d0) do { s16x4 l0, l1, l2, l3, h0, h1, h2, h3; constexpr int b_ = OFF_V + VB * SHM_V + v_rd_off(d0, 0, 0);   \
        TRRD(l0, b_); TRRD(h0, b_ + 2048); TRRD(l1, b_ + 4096); TRRD(h1, b_ + 6144); TRRD(l2, b_ + 8192); TRRD(h2, b_ + 10240); TRRD(l3, b_ + 12288); TRRD(h3, b_ + 14336); \
        asm volatile("s_waitcnt lgkmcnt(0)" ::: "memory"); SBAR();                                                              \
        o[d0] = __builtin_amdgcn_mfma_f32_32x32x16_bf16(pa0, (bf16x8){l0[0], l0[1], l0[2], l0[3], h0[0], h0[1], h0[2], h0[3]}, o[d0], 0, 0, 0);   \
        o[d0] = __builtin_amdgcn_mfma_f32_32x32x16_bf16(pa1, (bf16x8){l1[0], l1[1], l1[2], l1[3], h1[0], h1[1], h1[2], h1[3]}, o[d0], 0, 0, 0);   \
        o[d0] = __builtin_amdgcn_mfma_f32_32x32x16_bf16(pa2, (bf16x8){l2[0], l2[1], l2[2], l2[3], h2[0], h2[1], h2[2], h2[3]}, o[d0], 0, 0, 0);   \
        o[d0] = __builtin_amdgcn_mfma_f32_32x32x16_bf16(pa3, (bf16x8){l3[0], l3[1], l3[2], l3[3], h3[0], h3[1], h3[2], h3[3]}, o[d0], 0, 0, 0); } while (0)
    PV_D0(0); PV_D0(1); PV_D0(2); PV_D0(3);
#undef PV_D0
#undef TRRD
}
struct Tensors { const bf16_t* QN; const bf16_t* QR; const bf16_t* KN; const bf16_t* KR; const bf16_t* V; bf16_t* O; };
#define PK4(P, B_, OUT) do { unsigned a0 = cvt_pk_bf16(P[B_+0], P[B_+1]), a1 = cvt_pk_bf16(P[B_+2], P[B_+3]);                          \
        unsigned b0 = cvt_pk_bf16(P[B_+4], P[B_+5]), b1 = cvt_pk_bf16(P[B_+6], P[B_+7]);                                             \
        auto r0 = __builtin_amdgcn_permlane32_swap(a0, b0, false, false); auto r1 = __builtin_amdgcn_permlane32_swap(a1, b1, false, false); \
        u32x4 w = {r0[0], r1[0], r0[1], r1[1]}; OUT = *reinterpret_cast<bf16x8*>(&w); } while (0)
template <int KB> __device__ __forceinline__ bf16x8 kfrag(const char* lds, int r32, int hi, int g) {
    if (g < 16) { const int d0 = g >> 1; const char* a = lds + OFF_K + KB * SHM_K + KSWZ(r32, ((d0 & 3) * 16 + hi * 8) * 2) + (d0 >> 2) * 128 + (g & 1) * 32 * 256; return *reinterpret_cast<const bf16x8*>(a); }
    const int dd = (g - 16) >> 1; const char* a = lds + OFF_R + KB * SHM_R + RSWZ(r32, (dd * 16 + hi * 8) * 2) + (g & 1) * 32 * 128; return *reinterpret_cast<const bf16x8*>(a);
}
template <int KB> __device__ __forceinline__ void phase_a(f32x16& x0, f32x16& x1, f32x16& y0, f32x16& y1, float& l_reg, float alY, bf16x8& pa0, bf16x8& pa1, bf16x8& pa2, bf16x8& pa3,
                                                            const char* lds, int r32, int hi, const bf16x8* qr, const char* qrl, bool act, float cinit) {
    if (!act) cinit = -__builtin_inff();
#pragma unroll
    for (int r = 0; r < 16; ++r) { x0[r] = cinit; x1[r] = cinit; }
    bf16x8 kf[26]; bf16x8 qf[4]; float sacc = 0.f;
    kf[0] = kfrag<KB>(lds, r32, hi, 0); kf[1] = kfrag<KB>(lds, r32, hi, 1);
#pragma unroll
    for (int g = 0; g < 24; ++g) {
        if (g + 2 < 24) kf[g + 2] = kfrag<KB>(lds, r32, hi, g + 2);
        if (g >= 14 && g < 22 && (g & 1) == 0) qf[(g - 14) >> 1] = *reinterpret_cast<const bf16x8*>(qrl + ((g - 14) >> 1) * 1024);
        if (g < 16) { if (g & 1) x1 = __builtin_amdgcn_mfma_f32_32x32x16_bf16(kf[g], qr[g >> 1], x1, 0, 0, 0); else x0 = __builtin_amdgcn_mfma_f32_32x32x16_bf16(kf[g], qr[g >> 1], x0, 0, 0, 0);
            y0[g] = __builtin_amdgcn_exp2f(y0[g]); y1[g] = __builtin_amdgcn_exp2f(y1[g]); sacc += y0[g]; sacc += y1[g]; }
        else { if (g & 1) x1 = __builtin_amdgcn_mfma_f32_32x32x16_bf16(kf[g], qf[(g - 16) >> 1], x1, 0, 0, 0); else x0 = __builtin_amdgcn_mfma_f32_32x32x16_bf16(kf[g], qf[(g - 16) >> 1], x0, 0, 0, 0);
            if (g == 16) PK4(y0, 0, pa0); if (g == 18) PK4(y0, 8, pa1); if (g == 20) PK4(y1, 0, pa2); if (g == 22) PK4(y1, 8, pa3); }
        SBAR();
    }
    { auto rr = __builtin_amdgcn_permlane32_swap(__float_as_uint(sacc), __float_as_uint(sacc), false, false); sacc = __uint_as_float(rr[0]) + __uint_as_float(rr[1]); }
    l_reg = l_reg * alY + sacc;
}
__device__ __forceinline__ void finish_tail(f32x16& y0, f32x16& y1, float& l_reg, float alY, bf16x8& pa0, bf16x8& pa1, bf16x8& pa2, bf16x8& pa3) {
    float sacc = 0.f;
#pragma unroll
    for (int r = 0; r < 16; ++r) { y0[r] = __builtin_amdgcn_exp2f(y0[r]); y1[r] = __builtin_amdgcn_exp2f(y1[r]); sacc += y0[r]; sacc += y1[r]; }
    PK4(y0, 0, pa0); PK4(y0, 8, pa1); PK4(y1, 0, pa2); PK4(y1, 8, pa3);
    { auto rr = __builtin_amdgcn_permlane32_swap(__float_as_uint(sacc), __float_as_uint(sacc), false, false); sacc = __uint_as_float(rr[0]) + __uint_as_float(rr[1]); }
    l_reg = l_reg * alY + sacc;
}
template <int VB, bool WITH_MAX> __device__ __forceinline__ void phase_b(f32x16* o, int vb0, bf16x8 pa0, bf16x8 pa1, bf16x8 pa2, bf16x8 pa3, f32x16& x0, f32x16& x1, float& m_reg, float& alpha) {
#define TRRD(dst, off) asm volatile("ds_read_b64_tr_b16 %0, %1 offset:%2" : "=&v"(dst) : "v"(vb0), "i"(off) : "memory")
#define PVG(d0) do { s16x4 l0, l1, l2, l3, h0, h1, h2, h3; constexpr int b_ = OFF_V + VB * SHM_V + v_rd_off(d0, 0, 0);   \
        TRRD(l0, b_); TRRD(h0, b_ + 2048); TRRD(l1, b_ + 4096); TRRD(h1, b_ + 6144); TRRD(l2, b_ + 8192); TRRD(h2, b_ + 10240); TRRD(l3, b_ + 12288); TRRD(h3, b_ + 14336); \
        asm volatile("s_waitcnt lgkmcnt(0)" ::: "memory"); SBAR();                                                              \
        o[d0] = __builtin_amdgcn_mfma_f32_32x32x16_bf16(pa0, (bf16x8){l0[0], l0[1], l0[2], l0[3], h0[0], h0[1], h0[2], h0[3]}, o[d0], 0, 0, 0);   \
        o[d0] = __builtin_amdgcn_mfma_f32_32x32x16_bf16(pa1, (bf16x8){l1[0], l1[1], l1[2], l1[3], h1[0], h1[1], h1[2], h1[3]}, o[d0], 0, 0, 0);   \
        o[d0] = __builtin_amdgcn_mfma_f32_32x32x16_bf16(pa2, (bf16x8){l2[0], l2[1], l2[2], l2[3], h2[0], h2[1], h2[2], h2[3]}, o[d0], 0, 0, 0);   \
        o[d0] = __builtin_amdgcn_mfma_f32_32x32x16_bf16(pa3, (bf16x8){l3[0], l3[1], l3[2], l3[3], h3[0], h3[1], h3[2], h3[3]}, o[d0], 0, 0, 0); } while (0)
    PVG(0);
    float pmax = 0.f;
    if constexpr (WITH_MAX) {
        pmax = x0[0];
#pragma unroll
        for (int r = 1; r < 16; ++r) pmax = fmaxf(pmax, x0[r]);
#pragma unroll
        for (int r = 0; r < 16; ++r) pmax = fmaxf(pmax, x1[r]);
    }
    SBAR(); PVG(1);
    if constexpr (WITH_MAX) { auto rr = __builtin_amdgcn_permlane32_swap(__float_as_uint(pmax), __float_as_uint(pmax), false, false); pmax = fmaxf(__uint_as_float(rr[0]), __uint_as_float(rr[1])); }
    SBAR(); PVG(2); SBAR(); PVG(3);
    alpha = 1.f;
    if constexpr (WITH_MAX) {
        if (__builtin_expect(!__all(pmax <= THR2), 0)) { const float d = fmaxf(pmax, 0.f); alpha = __builtin_amdgcn_exp2f(-d); m_reg += d;
#pragma unroll
            for (int r = 0; r < 16; ++r) { x0[r] -= d; x1[r] -= d; } }
    }
#undef PVG
#undef TRRD
}
__device__ __forceinline__ void attn_block(const Tensors& T, int b, int h, int qb, char* lds) {
    int tid = threadIdx.x; asm volatile("" : "+v"(tid));
    const int wid = __builtin_amdgcn_readfirstlane(tid >> 6), lane = tid & 63, r32 = lane & 31, hi = lane >> 5;
    const size_t base = (size_t)b * SEQ;
    const int q0 = qb * QB, NT = q0 / KVBLK + 4, qlo = q0 + wid * QBLK;
    float* ws = (float*)(lds + OFF_WS) + wid * 64; float* li_l = ws, * al_l = ws + 32;
    float m_reg = -1e30f, l_reg = 0; f32x16 o[4] = {};
    const int vb0 = (int)(uintptr_t)lds + v_rd_base(lane);
    unsigned ko[2], vo[2], ro;
#pragma unroll
    for (int jj = 0; jj < 2; ++jj) { const int ofs = (jj * 8 + wid) * 1024 + lane * 16;
        { const int row = ofs >> 8, colB = (ofs & 255) ^ ((row & 7) << 4); ko[jj] = (unsigned)(row * 2048 + (colB >> 1)); }
        { const int sub = ofs >> 9, within = ofs & 511, kk = ((sub >> 2) << 3) | (within >> 6), k = (kk & ~0xC) | ((kk & 4) << 1) | ((kk & 8) >> 1), c = (sub & 3) * 32 + ((within & 63) >> 1); vo[jj] = (unsigned)(k * 2048 + c); } }
    { const int ofs = wid * 1024 + lane * 16, row = ofs >> 7, colB = (ofs & 127) ^ ((row & 7) << 4); ro = (unsigned)(row * 64 + (colB >> 1)); }
    const bf16_t* Kh = T.KN + base * 2048 + h * 128; const bf16_t* Vh = T.V + base * 2048 + h * 128; const bf16_t* Rh = T.KR + base * 64;
    LAS unsigned char* l3 = (LAS unsigned char*)lds;
#define DMA_K(t, bf) do { const bf16_t* kp_ = Kh + (size_t)(t) * KVBLK * 2048; const bf16_t* rp_ = Rh + (size_t)(t) * KVBLK * 64;                                      \
        __builtin_amdgcn_global_load_lds((const unsigned*)(kp_ + ko[0]), (LAS unsigned*)(l3 + OFF_K + (bf) * SHM_K + wid * 1024), 16, 0, 0);                                 \
        __builtin_amdgcn_global_load_lds((const unsigned*)(kp_ + ko[1]), (LAS unsigned*)(l3 + OFF_K + (bf) * SHM_K + (8 + wid) * 1024), 16, 0, 0);                           \
        __builtin_amdgcn_global_load_lds((const unsigned*)(rp_ + ro), (LAS unsigned*)(l3 + OFF_R + (bf) * SHM_R + wid * 1024), 16, 0, 0); } while (0)
#define DMA_V(t, bf) do { const bf16_t* vp_ = Vh + (size_t)(t) * KVBLK * 2048;                                                                                           \
        __builtin_amdgcn_global_load_lds((const unsigned*)(vp_ + vo[0]), (LAS unsigned*)(l3 + OFF_V + (bf) * SHM_V + wid * 1024), 16, 0, 0);                                 \
        __builtin_amdgcn_global_load_lds((const unsigned*)(vp_ + vo[1]), (LAS unsigned*)(l3 + OFF_V + (bf) * SHM_V + (8 + wid) * 1024), 16, 0, 0); } while (0)
#define SYNC() do { asm volatile("s_waitcnt vmcnt(0) lgkmcnt(0)" ::: "memory"); __syncthreads(); } while (0)
#define RESC(a) do { if (__any((a) < 1.f)) { if (hi == 0) al_l[r32] = (a); asm volatile("s_waitcnt lgkmcnt(0)" ::: "memory");              \
                     for (int d_ = 0; d_ < 4; ++d_) for (int r = 0; r < 16; ++r) o[d_][r] *= al_l[crow(r, hi)]; } } while (0)
#define ACT(t) ((t) * KVBLK <= qlo)
    bf16x8 qr[8]; char* qrl = lds + OFF_QR + wid * 4096 + lane * 16;
    { const size_t qrow = base + q0 + wid * QBLK + r32;
#pragma unroll
      for (int d0 = 0; d0 < 8; ++d0) qr[d0] = *(const bf16x8*)(T.QN + qrow * 2048 + h * 128 + d0 * 16 + hi * 8);
#pragma unroll
      for (int d0 = 0; d0 < 4; ++d0) *(bf16x8*)(qrl + d0 * 1024) = *(const bf16x8*)(T.QR + qrow * 1024 + h * 64 + d0 * 16 + hi * 8); }
    DMA_K(0, 0); SYNC();
    f32x16 pA0, pA1, pB0, pB1; float alA = 1.f, alB = 1.f; bf16x8 pa0, pa1, pa2, pa3;
    DMA_K(1, 1); DMA_V(0, 0);
    { float mn_; qkt<0>(pA0, pA1, lds, r32, hi, qr, qrl, true, 0.f);
      float pmax = pA0[0];
#pragma unroll
      for (int r = 1; r < 16; ++r) pmax = fmaxf(pmax, pA0[r]);
#pragma unroll
      for (int r = 0; r < 16; ++r) pmax = fmaxf(pmax, pA1[r]);
      { auto rr = __builtin_amdgcn_permlane32_swap(__float_as_uint(pmax), __float_as_uint(pmax), false, false); pmax = fmaxf(__uint_as_float(rr[0]), __uint_as_float(rr[1])); }
      m_reg = pmax; mn_ = pmax;
#pragma unroll
      for (int r = 0; r < 16; ++r) { pA0[r] -= mn_; pA1[r] -= mn_; } }
    SYNC();
#define STEP(X0, X1, alX, Y0, Y1, alY, t, KB, VB) do {                                                                         \
        if ((t) + 1 < NT) DMA_K((t) + 1, (KB) ^ 1); DMA_V(t, (VB) ^ 1); SBAR();                                               \
        phase_a<KB>(X0, X1, Y0, Y1, l_reg, alY, pa0, pa1, pa2, pa3, lds, r32, hi, qr, qrl, ACT(t), -m_reg); SBAR();           \
        phase_b<VB, true>(o, vb0, pa0, pa1, pa2, pa3, X0, X1, m_reg, alX); SBAR();                                             \
        RESC(alX); SYNC(); } while (0)
    for (int t = 1; t + 1 < NT; t += 2) {
        STEP(pB0, pB1, alB, pA0, pA1, alA, t, 1, 0);
        STEP(pA0, pA1, alA, pB0, pB1, alB, t + 1, 0, 1);
    }
    STEP(pB0, pB1, alB, pA0, pA1, alA, NT - 1, 1, 0);
    finish_tail(pB0, pB1, l_reg, alB, pa0, pa1, pa2, pa3); SBAR();
    { float dm_, da_; phase_b<1, false>(o, vb0, pa0, pa1, pa2, pa3, pB0, pB1, dm_ = 0.f, da_); }
    if (hi == 0) li_l[r32] = l_reg; asm volatile("s_waitcnt lgkmcnt(0)" ::: "memory");
    float rli[16];
#pragma unroll
    for (int r = 0; r < 16; ++r) rli[r] = __builtin_amdgcn_rcpf(li_l[crow(r, hi)]);
    bf16_t* Ow = T.O + (base + q0 + wid * QBLK) * 2048 + h * 128;
    __syncthreads();
    { bf16_t* stg = (bf16_t*)(lds + OFF_V) + wid * 4096;
#pragma unroll
      for (int r = 0; r < 16; ++r) { const int orow = crow(r, hi);
#pragma unroll
          for (int d0 = 0; d0 < 4; ++d0) { const float v = o[d0][r] * rli[r]; stg[orow * 128 + d0 * 32 + r32] = (bf16_t)(cvt_pk_bf16(v, 0.f) & 0xffffu); } }
      asm volatile("s_waitcnt lgkmcnt(0)" ::: "memory");
#pragma unroll
      for (int i = 0; i < 8; ++i) { const int row = i * 4 + (lane >> 4), ch = lane & 15; const u32x4 v = *(const u32x4*)(stg + row * 128 + ch * 8); *(u32x4*)(Ow + (size_t)row * 2048 + ch * 8) = v; } }
    __syncthreads();
#undef DMA_K
#undef DMA_V
#undef SYNC
#undef RESC
#undef ACT
#undef STEP
}
#undef PK4
#undef KSWZ
#undef RSWZ
#undef SBAR
}

namespace thin {
struct Ctx { int lane, wave, gw, ngw, gt, ngt; LAS unsigned char* lds; };

struct TJob { const float* W; const float* gain; bf16_t* dst; int K, N, ldd, kind; };
__device__ __forceinline__ bf16_t* dst_ptr(const TJob& J, int s) {
    int row = s, koff = 0;
    switch (J.kind) {
        case 1: row = s < 512 ? 512 + s : 1024 + 2 * ((s - 512) & 31) + ((s - 512) >> 5); break;
        case 2: { const int h = s / 192, d = s - h * 192; row = d < 128 ? h * 128 + d : 2048 + h * 64 + 2 * ((d - 128) & 31) + ((d - 128) >> 5); } break;
        case 3: koff = ((s & 255) >> 7) * 512; break;
        case 4: if (s >= 4096) { const int t = (s - 4096) >> 7, r = (s - 4096) & 127; row = 2048 + 256 * t + 128 + r; } else if (s >= 2048) { const int t = (s - 2048) >> 7, r = (s - 2048) & 127; row = 2048 + 256 * t + r; } break;
        default: break;
    }
    return J.dst + (size_t)row * J.ldd + koff;
}
__device__ __forceinline__ void titem_load(const TJob& J, int item, int lane, f32x4 (&v)[8]) {
    const int nblk = J.N / 32, kb = item / nblk, nb = item - kb * nblk, k0 = 64 * kb, s0 = 32 * nb; const int rs = lane >> 3, c4 = (lane & 7) * 4;
#pragma unroll
    for (int i = 0; i < 8; ++i) v[i] = *(const f32x4*)(J.W + (size_t)(k0 + i * 8 + rs) * J.N + s0 + c4);
}
__device__ __forceinline__ void titem_finish(const TJob& J, int item, LAS float* scr, int lane, const f32x4 (&v)[8]) {
    const int nblk = J.N / 32, kb = item / nblk, nb = item - kb * nblk, k0 = 64 * kb, s0 = 32 * nb; const int rs = lane >> 3, c4 = (lane & 7) * 4;
#pragma unroll
    for (int i = 0; i < 8; ++i) { const int kk = i * 8 + rs; const float gv = J.gain ? J.gain[k0 + kk] : 1.0f;
#pragma unroll
        for (int e = 0; e < 4; ++e) scr[kk * 33 + c4 + e] = v[i][e] * gv; }
    LDS_WAIT(); asm volatile("" ::: "memory");
    const int c = lane & 7;
#pragma unroll
    for (int j = 0; j < 4; ++j) { const int n = (lane >> 3) + 8 * j; const LAS float* s = scr + (8 * c) * 33 + n;
        u32x4 o; o.x = cvt_pk_bf16(s[0 * 33], s[1 * 33]); o.y = cvt_pk_bf16(s[2 * 33], s[3 * 33]); o.z = cvt_pk_bf16(s[4 * 33], s[5 * 33]); o.w = cvt_pk_bf16(s[6 * 33], s[7 * 33]);
        *(u32x4*)(dst_ptr(J, s0 + n) + k0 + 8 * c) = o; }
    LDS_WAIT(); asm volatile("" ::: "memory");
}
__device__ __forceinline__ void transpose_item(const TJob& J, int item, LAS float* scr, int lane) { f32x4 v[8]; titem_load(J, item, lane, v); titem_finish(J, item, scr, lane, v); }
__device__ __forceinline__ void zero_win(const Ctx& C, bf16_t* base, int rows, size_t ld, int ncols) {
    const int cpr = ncols / 8; const long total = (long)rows * cpr;
    for (long i = C.gt; i < total; i += C.ngt) { const long r = i / cpr; const int c = (int)(i - r * cpr); *(u32x4*)(base + r * ld + c * 8) = (u32x4){0u, 0u, 0u, 0u}; }
}
__device__ __forceinline__ void x_to_bf16(const Ctx& C, const float* xp, const float* xs, bf16_t* XB, float* ssq) {
    for (int row = C.gw; row < MT; row += C.ngw) {
        const float* src = row < MP ? xp + (size_t)row * DM : xs + (size_t)(row - MP) * DM;
        float s = 0.f;
#pragma unroll
        for (int j = 0; j < 8; ++j) { const f32x4 v = *(const f32x4*)(src + 4 * C.lane + 256 * j); s += epi::sq4(v);
            u32x2 w; w.x = cvt_pk_bf16(v[0], v[1]); w.y = cvt_pk_bf16(v[2], v[3]); *(u32x2*)(XB + (size_t)row * DM + 4 * C.lane + 256 * j) = w; }
        s = wave_sum(s);
        if (C.lane < 32) ssq[(size_t)row * 32 + C.lane] = C.lane == 0 ? s : 0.f;
    }
}
__device__ __forceinline__ void cs_table(const Ctx& C, float* cs) {
    for (int i = C.gt; i < NPOS * 32; i += C.ngt) { const int pos = i >> 5, p = i & 31;
        const float inv = powf(10000.0f, -(float)p / 32.0f); const float ang = (float)pos * inv; float sn, cn; sincosf(ang, &sn, &cn);
        cs[(size_t)i * 2] = cn; cs[(size_t)i * 2 + 1] = sn; }
}
__device__ __forceinline__ void citem_load(const float* ckv, int item, int lane, f32x4 (&v)[8]) {
    const int db = item & 15, kt = (item >> 4) & 63, jb = item >> 10;
    const float* src = ckv + ((size_t)jb * PAST + kt * 64) * 512 + db * 32; const int rs = lane >> 3, c4 = (lane & 7) * 4;
#pragma unroll
    for (int i = 0; i < 8; ++i) v[i] = *(const f32x4*)(src + (size_t)(i * 8 + rs) * 512 + c4);
}
__device__ __forceinline__ void citem_finish(bf16_t* KC, bf16_t* VT, int item, LAS float* scr, int lane, const f32x4 (&v)[8]) {
    const int db = item & 15, kt = (item >> 4) & 63, jb = item >> 10; const int rs = lane >> 3, c4 = (lane & 7) * 4;
#pragma unroll
    for (int i = 0; i < 8; ++i) { const int kk = i * 8 + rs;
#pragma unroll
        for (int e = 0; e < 4; ++e) scr[kk * 33 + c4 + e] = v[i][e]; }
    LDS_WAIT(); asm volatile("" ::: "memory");
    const int c = lane & 7;
    bf16_t* vt = VT + (size_t)jb * 512 * KEYP + (size_t)(db * 32) * KEYP + kt * 64;
#pragma unroll
    for (int j = 0; j < 4; ++j) { const int n = (lane >> 3) + 8 * j; const LAS float* s = scr + (8 * c) * 33 + n;
        u32x4 o; o.x = cvt_pk_bf16(s[0 * 33], s[1 * 33]); o.y = cvt_pk_bf16(s[2 * 33], s[3 * 33]); o.z = cvt_pk_bf16(s[4 * 33], s[5 * 33]); o.w = cvt_pk_bf16(s[6 * 33], s[7 * 33]);
        *(u32x4*)(vt + (size_t)n * KEYP + 8 * c) = o; }
    const int kq = lane & 3;
#pragma unroll
    for (int j = 0; j < 4; ++j) { const int key = (lane >> 2) + 16 * j; const LAS float* s = scr + key * 33 + 8 * kq;
        u32x4 o; o.x = cvt_pk_bf16(s[0], s[1]); o.y = cvt_pk_bf16(s[2], s[3]); o.z = cvt_pk_bf16(s[4], s[5]); o.w = cvt_pk_bf16(s[6], s[7]);
        *(u32x4*)(KC + ((size_t)jb * KEYP + kt * 64 + key) * QLD + db * 32 + 8 * kq) = o; }
    LDS_WAIT(); asm volatile("" ::: "memory");
}
__device__ __forceinline__ void cache_item(const float* ckv, bf16_t* KC, bf16_t* VT, int item, LAS float* scr, int lane) { f32x4 v[8]; citem_load(ckv, item, lane, v); citem_finish(KC, VT, item, scr, lane, v); }
__device__ __forceinline__ void cache_convert(const Ctx& C, const float* ckv, bf16_t* KC) {
    const long NR = (long)2 * DB * PAST;
    for (long r0 = C.gw; r0 < NR; r0 += 4L * C.ngw) { f32x4 a[4], b[4];
#pragma unroll
        for (int k = 0; k < 4; ++k) { const long r = r0 + (long)k * C.ngw; if (r < NR) { const float* src = ckv + r * 512 + 8 * C.lane; a[k] = *(const f32x4*)src; b[k] = *(const f32x4*)(src + 4); } }
#pragma unroll
        for (int k = 0; k < 4; ++k) { const long r = r0 + (long)k * C.ngw; if (r < NR) { const long jb = r >> 12; const int key = (int)(r & (PAST - 1));
            *(u32x4*)(KC + ((size_t)jb * KEYP + key) * QLD + 8 * C.lane) = epi::pack8(a[k], b[k]); } } }
}
__device__ __forceinline__ void krope_convert(const Ctx& C, const float* ckr, bf16_t* KC) {
    const long total = (long)2 * DB * PAST * 8;
    for (long i = C.gt; i < total; i += C.ngt) { const int c = (int)(i & 7); const long key = i >> 3; const long jb = key >> 12; const int k = (int)(key & (PAST - 1));
        const float* src = ckr + key * 64; const f32x4 a = *(const f32x4*)(src + 4 * c), b = *(const f32x4*)(src + 32 + 4 * c);
        u32x4 o; o.x = cvt_pk_bf16(a[0], b[0]); o.y = cvt_pk_bf16(a[1], b[1]); o.z = cvt_pk_bf16(a[2], b[2]); o.w = cvt_pk_bf16(a[3], b[3]);
        *(u32x4*)(KC + ((size_t)jb * KEYP + k) * QLD + 512 + 8 * c) = o; }
}
__device__ __forceinline__ void ckv_norm(const Ctx& C, const float* KVRAW, const float* ssqkv, const float* gkv, float* ockp, float* ocks, bf16_t* CKV, bf16_t* KC) {
    for (int row = C.gw; row < MT; row += C.ngw) {
        const f32x4 pa = *(const f32x4*)(ssqkv + (size_t)row * 8), pb = *(const f32x4*)(ssqkv + (size_t)row * 8 + 4);
        const float s = ((pa[0] + pa[1]) + (pa[2] + pa[3])) + ((pb[0] + pb[1]) + (pb[2] + pb[3]));
        const float r = 1.0f / sqrtf(s * (1.0f / 512.0f) + EPS);
#pragma unroll
        for (int j = 0; j < 2; ++j) { const int col = 4 * C.lane + 256 * j;
            const u32x2 rw = *(const u32x2*)((const bf16_t*)KVRAW + (size_t)row * 512 + col);
            const f32x4 v = (f32x4){__uint_as_float(rw.x << 16), __uint_as_float(rw.x & 0xffff0000u), __uint_as_float(rw.y << 16), __uint_as_float(rw.y & 0xffff0000u)} * r * *(const f32x4*)(gkv + col);
            u32x2 w; w.x = cvt_pk_bf16(v[0], v[1]); w.y = cvt_pk_bf16(v[2], v[3]);
            if (row < MP) { *(f32x4*)(ockp + (size_t)row * 512 + col) = v; *(u32x2*)(CKV + (size_t)row * 512 + col) = w; }
            else { const int tok = row - MP, b = tok >> 5, t = tok & 31; *(f32x4*)(ocks + (size_t)tok * 512 + col) = v;
                *(u32x2*)(KC + ((size_t)b * KEYP + PAST + t) * QLD + col) = w; } }
    }
}
__device__ __forceinline__ void softmax_rows(const Ctx& C, const bf16_t* S, bf16_t* P) {
    for (int row = C.gw; row < DB * 512; row += C.ngw) {
        const bf16_t* sp = S + (size_t)row * KEYP + 8 * C.lane; float v[9][8]; float mx = -__builtin_inff();
#pragma unroll
        for (int i = 0; i < 9; ++i) { if (i < 8 || C.lane < 4) { const u32x4 w = *(const u32x4*)(sp + 512 * i);
#pragma unroll
                for (int e = 0; e < 4; ++e) { v[i][2 * e] = __uint_as_float(w[e] << 16); v[i][2 * e + 1] = __uint_as_float(w[e] & 0xffff0000u); mx = fmaxf(mx, fmaxf(v[i][2 * e], v[i][2 * e + 1])); } }
            else {
#pragma unroll
                for (int e = 0; e < 8; ++e) v[i][e] = 0.f; } }
        mx = wave_max(mx); float l = 0.f;
#pragma unroll
        for (int i = 0; i < 9; ++i) { if (i < 8 || C.lane < 4) {
#pragma unroll
                for (int e = 0; e < 8; ++e) { v[i][e] = __builtin_amdgcn_exp2f(v[i][e] - mx); l += v[i][e]; } } }
        l = wave_sum(l); const float il = 1.0f / l;
        bf16_t* pp = P + (size_t)row * KEYP + 8 * C.lane;
#pragma unroll
        for (int i = 0; i < 9; ++i) { if (i < 8 || C.lane < 32) { u32x4 w;
#pragma unroll
                for (int e = 0; e < 4; ++e) w[e] = cvt_pk_bf16(v[i][2 * e] * il, v[i][2 * e + 1] * il);
                *(u32x4*)(pp + 512 * i) = w; } }
    }
}
__device__ __forceinline__ void rowsum_inv(const Ctx& C, const float* LP, float* IL, bool exact_ran) {
    for (int row = C.gw; row < DB * 512; row += C.ngw) {
        float s = LP[(size_t)row * LPP + C.lane] + (C.lane < 4 ? LP[(size_t)row * LPP + 64 + C.lane] : 0.f);
        s = wave_sum(s);
        if (C.lane == 0) IL[row] = exact_ran ? 1.0f : 1.0f / s; }
}
__device__ __forceinline__ void unpack8(const u32x4 w, float (&f)[8]) {
#pragma unroll
    for (int e = 0; e < 4; ++e) { f[2 * e] = __uint_as_float(w[e] << 16); f[2 * e + 1] = __uint_as_float(w[e] & 0xffff0000u); }
}
__device__ __forceinline__ void conv_pass(const Ctx& C, const bf16_t* GB, const bf16_t* U, const float* cw  , const float* st  , bf16_t* A2, const int row_lo = 0, const int row_hi = MT) {
    const long total = (long)(row_hi - row_lo) * 256;
    for (long i = C.gt; i < total; i += C.ngt) { const int row = row_lo + (int)(i >> 8), c = (int)(i & 255) * 8;
        float g[8], u0[8], u1[8], u2[8];
        unpack8(*(const u32x4*)(GB + (size_t)row * DM + c), g); unpack8(*(const u32x4*)(U + (size_t)row * DM + c), u2);
        int t; const float* s0 = nullptr;
        if (row < MP) t = row & (SEQ - 1); else { const int tok = row - MP; t = tok & 31; s0 = st + (size_t)(tok >> 5) * 2 * DM + c; }
        if (t >= 1) unpack8(*(const u32x4*)(U + (size_t)(row - 1) * DM + c), u1);
        else if (s0) { const f32x4 a = *(const f32x4*)(s0 + DM), b = *(const f32x4*)(s0 + DM + 4);
#pragma unroll
            for (int e = 0; e < 4; ++e) { u1[e] = a[e]; u1[4 + e] = b[e]; } }
        else {
#pragma unroll
            for (int e = 0; e < 8; ++e) u1[e] = 0.f; }
        if (t >= 2) unpack8(*(const u32x4*)(U + (size_t)(row - 2) * DM + c), u0);
        else if (s0) { const float* h = s0 + (size_t)t * DM; const f32x4 a = *(const f32x4*)(h), b = *(const f32x4*)(h + 4);
#pragma unroll
            for (int e = 0; e < 4; ++e) { u0[e] = a[e]; u0[4 + e] = b[e]; } }
        else {
#pragma unroll
            for (int e = 0; e < 8; ++e) u0[e] = 0.f; }
        float o[8];
#pragma unroll
        for (int e = 0; e < 8; ++e) o[e] = g[e] * (cw[c + e] * u0[e] + cw[DM + c + e] * u1[e] + cw[2 * DM + c + e] * u2[e]);
        u32x4 w; w.x = cvt_pk_bf16(o[0], o[1]); w.y = cvt_pk_bf16(o[2], o[3]); w.z = cvt_pk_bf16(o[4], o[5]); w.w = cvt_pk_bf16(o[6], o[7]);
        *(u32x4*)(A2 + (size_t)row * DM + c) = w; }
}
__device__ __forceinline__ void resid_finalize(const Ctx& C, const float* slab_, bf16_t* XB, float* ssq) {
    const bf16_t* slab = (const bf16_t*)slab_;
    for (int task = C.gw; task < MS * 2; task += C.ngw) { const int tok = task >> 1, half = task & 1, row = MP + tok; float s = 0.f;
#pragma unroll
        for (int j = 0; j < 2; ++j) { const int col = half * 1024 + 8 * C.lane + 512 * j; const u32x4 xo = *(const u32x4*)(XB + (size_t)row * DM + col);
            f32x4 v0 = (f32x4){__uint_as_float(xo.x << 16), __uint_as_float(xo.x & 0xffff0000u), __uint_as_float(xo.y << 16), __uint_as_float(xo.y & 0xffff0000u)};
            f32x4 v1 = (f32x4){__uint_as_float(xo.z << 16), __uint_as_float(xo.z & 0xffff0000u), __uint_as_float(xo.w << 16), __uint_as_float(xo.w & 0xffff0000u)};
            u32x4 p[8];
#pragma unroll
            for (int k = 0; k < 8; ++k) p[k] = *(const u32x4*)(slab + ((size_t)k * MS + tok) * DM + col);
#pragma unroll
            for (int k = 0; k < 8; ++k) {
                v0 += (f32x4){__uint_as_float(p[k].x << 16), __uint_as_float(p[k].x & 0xffff0000u), __uint_as_float(p[k].y << 16), __uint_as_float(p[k].y & 0xffff0000u)};
                v1 += (f32x4){__uint_as_float(p[k].z << 16), __uint_as_float(p[k].z & 0xffff0000u), __uint_as_float(p[k].w << 16), __uint_as_float(p[k].w & 0xffff0000u)}; }
            *(u32x4*)(XB + (size_t)row * DM + col) = epi::pack8(v0, v1); s += epi::sq4(v0) + epi::sq4(v1); }
        s = wave_sum(s);
        if (C.lane < 16) ssq[(size_t)row * 32 + half * 16 + C.lane] = C.lane == 0 ? s : 0.f; }
}
__device__ __forceinline__ void final_norm(const Ctx& C, const bf16_t* XB, const float* ssq, const float* g, float* yp, float* ys) {
    for (int row = C.gw; row < MT; row += C.ngw) {
        float s = C.lane < 32 ? ssq[(size_t)row * 32 + C.lane] : 0.f; s = wave_sum(s);
        const float r = 1.0f / sqrtf(s * (1.0f / DM) + EPS);
        float* dst = row < MP ? yp + (size_t)row * DM : ys + (size_t)(row - MP) * DM;
#pragma unroll
        for (int j = 0; j < 4; ++j) { const int col = 8 * C.lane + 512 * j; const u32x4 w = *(const u32x4*)(XB + (size_t)row * DM + col);
            const f32x4 a = (f32x4){__uint_as_float(w.x << 16), __uint_as_float(w.x & 0xffff0000u), __uint_as_float(w.y << 16), __uint_as_float(w.y & 0xffff0000u)};
            const f32x4 b = (f32x4){__uint_as_float(w.z << 16), __uint_as_float(w.z & 0xffff0000u), __uint_as_float(w.w << 16), __uint_as_float(w.w & 0xffff0000u)};
            *(f32x4*)(dst + col) = a * r * *(const f32x4*)(g + col); *(f32x4*)(dst + col + 4) = b * r * *(const f32x4*)(g + col + 4); }
    }
}
}

#define XB_TMO      128
#define XB_XCNT(j)  (256  + 64 * (j))
#define XB_XSUB(j)  (1280 + 64 * (j))
#define XB_XGEN(j)  (2304 + 64 * (j))
#define XB_TOP      3328
#define XB_TOPGEN   3392
#define XCD_BAR_WORDS 3456
#define XB_SPIN_CAP (1u << 18)

__device__ __forceinline__ unsigned xb_ld(unsigned* p)              { return __hip_atomic_load(p, __ATOMIC_RELAXED, __HIP_MEMORY_SCOPE_AGENT); }
__device__ __forceinline__ unsigned xb_add(unsigned* p, unsigned v) { return __hip_atomic_fetch_add(p, v, __ATOMIC_RELAXED, __HIP_MEMORY_SCOPE_AGENT); }
__device__ __forceinline__ unsigned xb_xcc_id() { return (unsigned)__builtin_amdgcn_s_getreg((3 << 11) | 20) & 0xFu; }
#define XB_SPIN(cond, bar) do { unsigned _sp = 0; while (cond) { __builtin_amdgcn_s_sleep(1); \
    if ((++_sp & 255u) == 0u) { if (xb_ld(&(bar)[XB_TMO])) break; if (_sp > XB_SPIN_CAP) { atomicAdd(&(bar)[XB_TMO], 1u); break; } } } } while (0)

struct XcdBarrier {
    unsigned* bar; unsigned x;
    volatile LAS unsigned* st;
};

__device__ __forceinline__ XcdBarrier xcd_barrier_post(unsigned* bar, volatile LAS unsigned* st) {
    XcdBarrier b; b.bar = bar; b.x = xb_xcc_id(); b.st = st;
    if (threadIdx.x == 0) (void)xb_add(&bar[XB_XCNT(b.x)], 1u);
    return b;
}
__device__ __forceinline__ void xcd_barrier_complete(unsigned* bar, unsigned x, unsigned& nloc, unsigned& nx) {
    const unsigned G = gridDim.x * gridDim.y * gridDim.z;
    unsigned sum, cnt, mine, sp = 0u;
    for (;;) {
        sum = 0u; cnt = 0u; mine = 0u;
#pragma unroll
        for (unsigned j = 0; j < 16; ++j) { const unsigned c = xb_ld(&bar[XB_XCNT(j)]); sum += c; cnt += (c > 0u) ? 1u : 0u; mine = (j == x) ? c : mine; }
        if (sum == G) break;
        __builtin_amdgcn_s_sleep(1);
        if ((++sp & 255u) == 0u) { if (xb_ld(&bar[XB_TMO])) break; if (sp > XB_SPIN_CAP) { atomicAdd(&bar[XB_TMO], 1u); break; } }
    }
    nloc = mine > 0u ? mine : 1u; nx = cnt > 0u ? cnt : 1u;
}

__device__ __forceinline__ void xcd_barrier(const XcdBarrier& b) {
    asm volatile("s_waitcnt vmcnt(0)" ::: "memory");
    __syncthreads();
    if (threadIdx.x == 0) {
        unsigned* bar = b.bar;
        __builtin_amdgcn_s_waitcnt(0);
        unsigned nloc = b.st[0], nx = b.st[1];
        if (nloc == 0u) { xcd_barrier_complete(bar, b.x, nloc, nx); b.st[0] = nloc; b.st[1] = nx; }
        const unsigned old = xb_add(&bar[XB_XSUB(b.x)], 1u);
        const unsigned gen = old / nloc;
        if (old + 1u == (gen + 1u) * nloc) {
            __builtin_amdgcn_fence(__ATOMIC_RELEASE, "agent");
            asm volatile("s_waitcnt vmcnt(0)" ::: "memory");
            const unsigned og = xb_add(&bar[XB_TOP], 1u);
            const unsigned tg = og / nx;
            if (og + 1u == (tg + 1u) * nx) xb_add(&bar[XB_TOPGEN], 1u);
            else XB_SPIN(xb_ld(&bar[XB_TOPGEN]) == tg, bar);
            __builtin_amdgcn_fence(__ATOMIC_ACQUIRE, "agent");
            xb_add(&bar[XB_XGEN(b.x)], 1u);
            asm volatile("s_waitcnt vmcnt(0)" ::: "memory");
        } else {
            XB_SPIN(xb_ld(&bar[XB_XGEN(b.x)]) == gen, bar);
            __builtin_amdgcn_fence(__ATOMIC_ACQUIRE, "agent");
            asm volatile("s_waitcnt vmcnt(0)" ::: "memory");
        }
    }
    __syncthreads();
}

constexpr int NWAVES = 8;
constexpr int RING_BYTES = 131072, MISC_OFF = RING_BYTES + 320, LDS_BYTES = 147456;
constexpr int N_PHASES = 38;

struct Args {
    const float *x_prompt, *x_sample, *cache_ckv, *cache_krope, *state_conv, *norm_mix, *w_dq, *g_q, *w_uq, *w_dkv, *g_kv, *w_uk, *w_uv, *w_o, *w_in, *conv_w, *w_out, *norm_ffn, *w_ff1, *w_ff2, *norm_final;
    float* out; unsigned char* ws; int ph_lo, ph_hi;
};

struct SchedQlat {
    int G, c;
    __device__ __forceinline__ bool next(int i, pg8::Unit& u, size_t& aoff, size_t& boff, int& unt) const { const int L = i * G + c; if (L >= 128) return false;
        u.z = L >> 3; u.pm = (L >> 1) & 3; u.pn = L & 1; aoff = ((size_t)(MP + u.pm * 256) * 2048 + u.z * 128) * 2; boff = ((size_t)(u.pn * 256) * 2048 + u.z * 128) * 2; return true; }
};
struct SchedScores {
    int G, c;
    __device__ __forceinline__ bool next(int i, pg8::Unit& u, size_t& aoff, size_t& boff, int& unt) const { const int L = i * G + c; if (L >= DB * 34) return false;
        u.z = L / 34; const int r = L - u.z * 34; u.pm = r / 17; u.pn = r - u.pm * 17;
        aoff = ((size_t)(u.z * 512 + u.pm * 256) * QLD) * 2; boff = ((size_t)(u.z * KEYP + u.pn * 256) * QLD) * 2; return true; }
};
struct SchedPV {
    int G, c;
    __device__ __forceinline__ bool next(int i, pg8::Unit& u, size_t& aoff, size_t& boff, int& unt) const { int L = i * G + c; if (L >= DB * 4) return false;
        if (G == 256) { const int x = c & 7, s = c >> 3; L = ((x + 8 * (s >> 1)) << 1) | (s & 1); }
        u.z = L >> 2; u.pm = (L >> 1) & 1; u.pn = L & 1;
        aoff = ((size_t)(u.z * 512 + u.pm * 256) * KEYP) * 2; boff = ((size_t)u.z * KEYP * QLD + u.pn * 256) * 2; return true; }
};
struct SchedO2 {
    int G, c;
    __device__ __forceinline__ bool next(int i, pg8::Unit& u, size_t& aoff, size_t& boff, int& unt) const { const int L = i * G + c; if (L >= 32) return false;
        u.z = 0; u.pm = L >> 3; u.pn = L & 7; aoff = ((size_t)(u.pm * 256) * 8192 + u.pn * 1024) * 2; boff = ((size_t)(u.pn * 256) * 1024) * 2; return true; }
};


struct SchedResid {
    pg8::SchedMN P; int G, c, nt8, L0; size_t astep, bstep; bool krev;
    __device__ __forceinline__ void init(int G_, int c_, int lda, int ldb, int nt, bool krev_, int L0_ = 0) { G = G_; c = c_; krev = krev_; L0 = L0_; nt8 = nt / 8; astep = (size_t)256 * lda * 2; bstep = (size_t)256 * ldb * 2; P.init(MP / 256, 8, G_, c_, astep, bstep, lda > 2048 ? 4 : 8); }
    __device__ __forceinline__ bool next(int i, pg8::Unit& u, size_t& aoff, size_t& boff, int& unt) const {
        const int L = i * G + c + L0;
        if (L < 512) { unt = nt8 * 8; const bool ok = P.map(L, u, aoff, boff); if (krev && (i & 1) == 0) { aoff += (size_t)(nt8 * 8 - 1) * 128; boff += (size_t)(nt8 * 8 - 1) * 128; unt = -unt; } return ok; }
        const int s = L - 512; if (s >= 256) return false;
        const int ks = s & 7; u.pn = (s >> 3) & 7; u.pm = 64 + (s >> 6); u.z = 1 + ks; unt = nt8;
        aoff = (size_t)u.pm * astep + (size_t)ks * nt8 * 128; boff = (size_t)u.pn * bstep + (size_t)ks * nt8 * 128; return true; }
};
struct SchedWinA {
    pg8::SchedMN P; int G, c;
    __device__ __forceinline__ void init(int G_, int c_) { G = G_; c = c_; P.init(MT / 256, 16, G_, c_, (size_t)256 * 2048 * 2, (size_t)256 * 2048 * 2, pg8::WGM, 8); }
    __device__ __forceinline__ bool next(int i, pg8::Unit& u, size_t& aoff, size_t& boff, int& unt) const { const long L = (long)i * G + c;
        if (L < 1088) return P.map(L, u, aoff, boff);
        const int s = (int)(L - 1088); if (s >= 32) return false;
        u.pm = 64 + (s >> 3); u.pn = s & 7; u.z = 0; aoff = (size_t)u.pm * P.astep; boff = (size_t)u.pn * P.bstep; return true; }
};
struct SchedEarlyMix {
    pg8::SchedMN P; int c2;
    __device__ __forceinline__ void init(int G_, int bx) { c2 = bx - 128; P.init(MP / 256, 8, G_, bx, (size_t)256 * 2048 * 2, (size_t)256 * 2048 * 2); }
    __device__ __forceinline__ bool next(int i, pg8::Unit& u, size_t& aoff, size_t& boff, int& unt) const { if (c2 < 0 || i >= 2) return false; return P.map((long)i * 128 + c2, u, aoff, boff); }
};

__device__ __forceinline__ const Args& opq_args() { auto p = __builtin_amdgcn_kernarg_segment_ptr(); asm volatile("" : "+s"(p)); return *(const Args*)p; }
#define WSP(T, OFF) ((T*)(ws + (OFF)))
#define CS WSP(float, WS_CS)
#define SSQ WSP(float, WS_SSQ)
#define SSQCQ WSP(float, WS_SSQCQ)
#define SSQKV WSP(float, WS_SSQKV)
#define X WSP(float, WS_X)
#define XB WSP(bf16_t, WS_XB)
#define CQ WSP(bf16_t, WS_CQ)
#define KVRAW WSP(float, WS_KVRAW)
#define CKV WSP(bf16_t, WS_CKV)
#define KR WSP(bf16_t, WS_KR)
#define QN WSP(bf16_t, WS_QN)
#define QR WSP(bf16_t, WS_QR)
#define KN WSP(bf16_t, WS_KN)
#define VV WSP(bf16_t, WS_V)
#define GB WSP(bf16_t, WS_GB)
#define UU WSP(bf16_t, WS_U)
#define OB WSP(bf16_t, WS_O)
#define QL WSP(bf16_t, WS_QL)
#define OL WSP(bf16_t, WS_OL)
#define KC WSP(bf16_t, WS_KC)
#define VT WSP(bf16_t, WS_VT)
#define SS WSP(float, WS_S)
#define HB WSP(bf16_t, WS_HB)
#define PP WSP(bf16_t, WS_P)
#define W1 WSP(bf16_t, WS_W1)
#define W2 WSP(bf16_t, WS_W2)
#define W3 WSP(bf16_t, WS_W3)
#define WUK WSP(bf16_t, WS_WUK)
#define W5 WSP(bf16_t, WS_W5)
#define W6 WSP(bf16_t, WS_W6)
#define W10 WSP(bf16_t, WS_W10)
#define W9 WSP(bf16_t, WS_W9)
#define W7 WSP(bf16_t, WS_W7)
#define W8 WSP(bf16_t, WS_W8)

__global__ void __launch_bounds__(NWAVES * 64, 2) mk_fwd(Args args_) {
    extern __shared__ __attribute__((aligned(16))) unsigned char lds_raw[];
    LAS unsigned char* lds = (LAS unsigned char*)lds_raw;
    volatile LAS unsigned* MISC = (volatile LAS unsigned*)(lds + MISC_OFF);
    const int tid = threadIdx.x;
    const int G0 = gridDim.x, bx0 = blockIdx.x;
    unsigned* ctl = (unsigned*)(args_.ws + WS_CTL);
    for (int u = tid; u < (LDS_BYTES - RING_BYTES) / 4; u += NWAVES * 64) ((LAS unsigned*)(lds + RING_BYTES))[u] = 0u;
    __syncthreads();
    const int lo = args_.ph_lo, hi = args_.ph_hi;
    const bool use_bar = (hi - lo) > 1;
    XcdBarrier bar; bar.bar = ctl + CW_BAR; bar.x = 0; bar.st = nullptr;
    if (use_bar) bar = xcd_barrier_post(ctl + CW_BAR, MISC + 8);

    int ph = 0;
#ifndef SITE_MASK
#define SITE_MASK 0xffffffffu
#endif
#define SITE(k) (((SITE_MASK) >> (k)) & 1u)
#ifndef REPEAT_MASK
#define REPEAT_MASK 0u
#endif
#define REPS(k) (1 + (int)(((REPEAT_MASK) >> (k)) & 1u) * REPEAT_N)
#ifndef REPEAT_N
#define REPEAT_N 1
#endif
#define PH_ON() (lo <= ph && ph < hi)
#define ssq_mix (SSQ + (size_t)(2 * i) * MT * 32)
#define ssq_ffn (SSQ + (size_t)(2 * i + 1) * MT * 32)
#define ssq_next (SSQ + (size_t)(2 * i + 2) * MT * 32)
#define KCj (KC + (size_t)j * DB * KEYP * QLD)
#define VTj (VT + (size_t)j * DB * 512 * KEYP)
#define CTX_LOCALS int tid_ = threadIdx.x; asm volatile("" : "+v"(tid_)); thin::Ctx C; C.lane = tid_ & 63; C.wave = __builtin_amdgcn_readfirstlane(tid_ >> 6); C.gw = bx * NWAVES + C.wave; C.ngw = G * NWAVES; C.gt = bx * (NWAVES * 64) + tid_; C.ngt = G * NWAVES * 64; C.lds = lds
#define SITE_LOCALS int G = G0, bx = bx0; asm volatile("" : "+s"(G), "+s"(bx)); const Args& args = opq_args(); unsigned char* const ws = args.ws; float* const out = args.out; (void)ws; (void)out
#define PH_END() do { if (use_bar && lo <= ph && ph + 1 < hi) xcd_barrier(bar); ++ph; } while (0)

    if (SITE(0) && PH_ON()) for (int rep_ = 0; rep_ < REPS(0); ++rep_) { SITE_LOCALS; CTX_LOCALS; const int lane = C.lane, wave = C.wave;
        LAS float* scr = (LAS float*)(lds + wave * 16384);
        thin::cache_convert(C, args.cache_ckv, KC);
        thin::krope_convert(C, args.cache_krope, KC);
        for (int jr = 0; jr < 26; ++jr) { const int job = 25 - jr;
            thin::TJob J; J.gain = nullptr; J.kind = 0;
            if (job < 14) { const int j = job / 7, k = job - j * 7;
                switch (k) {
                    case 0: J.W = args.w_dq + (size_t)j * 2048 * 512; J.K = 2048; J.N = 512; J.gain = args.norm_mix + (size_t)(2 * j) * DM; J.dst = W1 + (size_t)j * 1280 * 2048; J.ldd = 2048; break;
                    case 1: J.W = args.w_dkv + (size_t)j * 2048 * 576; J.K = 2048; J.N = 576; J.gain = args.norm_mix + (size_t)(2 * j) * DM; J.dst = W1 + (size_t)j * 1280 * 2048; J.ldd = 2048; J.kind = 1; break;
                    case 2: J.W = args.w_uq + (size_t)j * 512 * 3072; J.K = 512; J.N = 3072; J.gain = args.g_q + (size_t)j * 512; J.dst = W2 + (size_t)j * 3072 * 512; J.ldd = 512; J.kind = 2; break;
                    case 3: J.W = args.w_uk + (size_t)j * 512 * 2048; J.K = 512; J.N = 2048; J.dst = W3 + (size_t)j * 4096 * 512; J.ldd = 512; break;
                    case 4: J.W = args.w_uv + (size_t)j * 512 * 2048; J.K = 512; J.N = 2048; J.dst = W3 + (size_t)j * 4096 * 512 + (size_t)2048 * 512; J.ldd = 512; break;
                    case 5: J.W = args.w_uv + (size_t)j * 512 * 2048; J.K = 512; J.N = 2048; J.dst = W5 + (size_t)j * 2048 * 1024; J.ldd = 1024; J.kind = 3; break;
                    default: J.W = args.w_o + (size_t)j * 2048 * 2048; J.K = 2048; J.N = 2048; J.dst = W6 + (size_t)j * 2048 * 2048; J.ldd = 2048; break;
                } }
            else if (job < 18) { const int j = (job - 14) >> 1;
                if (((job - 14) & 1) == 0) { J.W = args.w_in + (size_t)j * 2048 * 6144; J.K = 2048; J.N = 6144; J.gain = args.norm_mix + (size_t)(2 * j + 1) * DM; J.dst = W9 + (size_t)j * 6144 * 2048; J.ldd = 2048; J.kind = 4; }
                else { J.W = args.w_out + (size_t)j * 2048 * 2048; J.K = 2048; J.N = 2048; J.dst = W10 + (size_t)j * 2048 * 2048; J.ldd = 2048; } }
            else { const int i = (job - 18) >> 1;
                if (((job - 18) & 1) == 0) { J.W = args.w_ff1 + (size_t)i * 2048 * 8192; J.K = 2048; J.N = 8192; J.gain = args.norm_ffn + (size_t)i * DM; J.dst = W7 + (size_t)i * 8192 * 2048; J.ldd = 2048; }
                else { J.W = args.w_ff2 + (size_t)i * 8192 * 2048; J.K = 8192; J.N = 2048; J.dst = W8 + (size_t)i * 2048 * 8192; J.ldd = 8192; } }
            const int nitems = (J.K / 64) * (J.N / 32);
            for (int it = C.gw; it < nitems; it += C.ngw) thin::transpose_item(J, it, scr, lane);
        }
        for (long i = C.gt; i < (long)2 * 512 * 2048 / 8; i += C.ngt) { const f32x4 a = *(const f32x4*)(args.w_uk + i * 8), b = *(const f32x4*)(args.w_uk + i * 8 + 4); *(u32x4*)(WUK + i * 8) = epi::pack8(a, b); }
        for (int j = 0; j < 2; ++j) {
            thin::zero_win(C, W1 + (size_t)j * 1280 * 2048 + (size_t)1088 * 2048, 192, 2048, 2048);
            for (int pn = 0; pn < 8; ++pn) { thin::zero_win(C, W5 + (size_t)j * 2048 * 1024 + (size_t)(pn * 256) * 1024 + 512, 128, 1024, 512);
                                              thin::zero_win(C, W5 + (size_t)j * 2048 * 1024 + (size_t)(pn * 256 + 128) * 1024, 128, 1024, 512); }
            thin::zero_win(C, KC + (size_t)j * DB * KEYP * QLD + 576, DB * KEYP, QLD, 64);
            for (int b = 0; b < DB; ++b) thin::zero_win(C, KC + ((size_t)(j * DB + b) * KEYP + NKEY) * QLD, KEYP - NKEY, QLD, 576);
        }
        thin::zero_win(C, QL + 576, MS * 16, QLD, 64);
        thin::cs_table(C, CS);
        thin::x_to_bf16(C, args.x_prompt, args.x_sample, XB, SSQ);
    }
    PH_END();

    for (int i = 0; i < DEPTH; ++i) {
        const int j = i >> 1;
        if ((i & 1) == 0) {
            if (SITE(1) && PH_ON()) for (int rep_ = 0; rep_ < REPS(1); ++rep_) { SITE_LOCALS;
                pg8::Gemm g{XB, W1 + (size_t)j * 1280 * 2048, 2048, 2048, 32}; pg8::SchedMN S; S.init(MT / 256, 5, G, bx, (size_t)256 * 2048 * 2, (size_t)256 * 2048 * 2);
                epi::EpiW1 E{ssq_mix, CS, CQ, SSQCQ, KVRAW, SSQKV, KR, KCj, out + O_KRP + (size_t)j * MP * 64, out + O_KRS + (size_t)j * MS * 64};
                pg8::gemm_phase(lds, g, S, E);
            }
            PH_END();
            if (SITE(2) && PH_ON()) for (int rep_ = 0; rep_ < REPS(2); ++rep_) { SITE_LOCALS; CTX_LOCALS; thin::ckv_norm(C, KVRAW, SSQKV, args.g_kv + (size_t)j * 512, out + O_CKVP + (size_t)j * MP * 512, out + O_CKVS + (size_t)j * MS * 512, CKV, KCj); }
            if (SITE(3) && PH_ON()) for (int rep_ = 0; rep_ < REPS(3); ++rep_) { SITE_LOCALS;
                pg8::Gemm g{CQ, W2 + (size_t)j * 3072 * 512, 512, 512, 8}; pg8::SchedMN S; S.init(MT / 256, 12, G, bx, (size_t)256 * 512 * 2, (size_t)256 * 512 * 2);
                epi::EpiW2 E{SSQCQ, CS, QN, QR, QL};
                pg8::gemm_phase(lds, g, S, E);
            }
            PH_END();
            if (SITE(4) && PH_ON()) for (int rep_ = 0; rep_ < REPS(4); ++rep_) { SITE_LOCALS;
                { pg8::Gemm g{CKV, W3 + (size_t)j * 4096 * 512, 512, 512, 8}; pg8::SchedMN S; S.init(MP / 256, 16, G, bx, (size_t)256 * 512 * 2, (size_t)256 * 512 * 2);
                  epi::EpiBf16<epi::MapW3> E{epi::MapW3{KN, VV}}; pg8::gemm_phase(lds, g, S, E); }
                { pg8::Gemm g{QN, WUK + (size_t)j * 512 * 2048, 2048, 2048, 2}; SchedQlat S{G, bx};
                  epi::EpiBf16<epi::MapQlat> E{epi::MapQlat{QL}}; pg8::gemm_phase(lds, g, S, E); }
            }
            PH_END();
            if (SITE(5) && PH_ON()) for (int rep_ = 0; rep_ < REPS(5); ++rep_) { SITE_LOCALS;
#ifndef ATT_REP
#define ATT_REP 1
#endif
                for (int ra_ = 0; ra_ < ATT_REP; ++ra_) { const att::Tensors T{QN, QR, KN, KR, VV, OB};
                  const int vcu = (G % 8 == 0) ? (bx % 8) * (G / 8) + bx / 8 : bx;
                  for (int id = vcu; id < 512; id += G) { const int bh = id >> 3, x = id & 7;
                      att::attn_block(T, bh >> 4, bh & 15, 15 - x, (char*)lds_raw); att::attn_block(T, bh >> 4, bh & 15, x, (char*)lds_raw); } }
                { pg8::Gemm g{QL, KCj, QLD, QLD, 10}; SchedScores S{G, bx}; epi::EpiScoresExp E{PP, WSP(float, WS_LP), (unsigned*)(ws + WS_CTL) + CW_SMFLAG + j}; pg8::gemm_phase(lds, g, S, E); }
            }
            PH_END();
            { bool exact_; { SITE_LOCALS; exact_ = use_bar && PH_ON() && __builtin_amdgcn_readfirstlane(__hip_atomic_load((unsigned*)(ws + WS_CTL) + CW_SMFLAG + j, __ATOMIC_RELAXED, __HIP_MEMORY_SCOPE_AGENT)) != 0u; }
              if (exact_) {
                { SITE_LOCALS; pg8::Gemm g{QL, KCj, QLD, QLD, 10}; SchedScores S{G, bx}; epi::EpiBf16<epi::MapScores> E{epi::MapScores{WSP(bf16_t, WS_S)}}; pg8::gemm_phase(lds, g, S, E); }
                xcd_barrier(bar);
                { SITE_LOCALS; CTX_LOCALS; thin::softmax_rows(C, WSP(bf16_t, WS_S), PP); }
                xcd_barrier(bar);
              }
              if (SITE(6) && PH_ON()) { SITE_LOCALS; CTX_LOCALS; thin::rowsum_inv(C, WSP(float, WS_LP), WSP(float, WS_IL), exact_); }
            }
            if (SITE(7) && PH_ON()) for (int rep_ = 0; rep_ < REPS(7); ++rep_) { SITE_LOCALS; pg8::Gemm g{PP, KCj, KEYP, QLD, 66};     SchedPV S{G, bx}; epi::EpiBf16NP<epi::MapPV> E{epi::MapPV{OL}}; pg8::gemm_phase<epi::EpiBf16NP<epi::MapPV>, SchedPV, true>(lds, g, S, E);
                { pg8::Gemm g2{OB, W6 + (size_t)j * 2048 * 2048, 2048, 2048, 32}; SchedEarlyMix S2; S2.init(G, bx); epi::EpiResid E2{XB, ssq_ffn, WSP(float, WS_SLAB)}; pg8::gemm_phase(lds, g2, S2, E2); } }
            PH_END();
            if (SITE(8) && PH_ON()) for (int rep_ = 0; rep_ < REPS(8); ++rep_) { SITE_LOCALS; pg8::Gemm g{OL, W5 + (size_t)j * 2048 * 1024, 8192, 1024, 16}; SchedO2 S{G, bx}; epi::EpiO2 E{OB, WSP(float, WS_IL)}; pg8::gemm_phase(lds, g, S, E); }
            PH_END();
        } else {
            if (SITE(9) && PH_ON()) { SITE_LOCALS;
                pg8::Gemm g{XB, W9 + (size_t)j * 6144 * 2048, 2048, 2048, 32}; SchedWinA S; S.init(G, bx);
                epi::EpiWin E{ssq_mix, GB, UU, out + O_CONVP + (size_t)j * NB * 2 * DM, out + O_CONVS + (size_t)j * DB * 2 * DM};
                pg8::gemm_phase(lds, g, S, E);
            }
            PH_END();
            if (SITE(10) && PH_ON()) { SITE_LOCALS;
                { CTX_LOCALS; thin::conv_pass(C, GB, UU, args.conv_w + (size_t)j * 3 * DM, args.state_conv + (size_t)j * DB * 2 * DM, OB, MP, MT); }
                pg8::Gemm g{XB, W9 + (size_t)j * 6144 * 2048, 2048, 2048, 32}; pg8::SchedMN S; S.init(MP / 256, 8, G, bx, (size_t)256 * 2048 * 2, (size_t)256 * 2048 * 2);
                epi::EpiGateConv E{ssq_mix, UU, args.conv_w + (size_t)j * 3 * DM, args.state_conv + (size_t)j * DB * 2 * DM, OB};
                pg8::gemm_phase(lds, g, S, E);
            }
            PH_END();
        }
        if (SITE(11) && PH_ON()) for (int rep_ = 0; rep_ < REPS(11); ++rep_) { SITE_LOCALS;
            pg8::Gemm g{OB, ((i & 1) == 0 ? W6 : W10) + (size_t)j * 2048 * 2048, 2048, 2048, 32}; SchedResid S; S.init(G, bx, 2048, 2048, 32, false, (i & 1) == 0 ? 256 : 0);
            epi::EpiResid E{XB, ssq_ffn, WSP(float, WS_SLAB)};
            pg8::gemm_phase(lds, g, S, E);
        }
        PH_END();
        if (SITE(15) && PH_ON()) { SITE_LOCALS; CTX_LOCALS; thin::resid_finalize(C, WSP(float, WS_SLAB), XB, ssq_ffn); }
        PH_END();
        if (SITE(12) && PH_ON()) for (int rep_ = 0; rep_ < REPS(12); ++rep_) { SITE_LOCALS;
            pg8::Gemm g{XB, W7 + (size_t)i * 8192 * 2048, 2048, 2048, 32}; pg8::SchedMN S; S.init(MT / 256, 32, G, bx, (size_t)256 * 2048 * 2, (size_t)256 * 2048 * 2);
            epi::EpiFF1 E{ssq_ffn, HB}; pg8::gemm_phase(lds, g, S, E);
        }
        PH_END();
        if (SITE(13) && PH_ON()) for (int rep_ = 0; rep_ < REPS(13); ++rep_) { SITE_LOCALS;
            pg8::Gemm g{HB, W8 + (size_t)i * 2048 * 8192, 8192, 8192, 128}; SchedResid S; S.init(G, bx, 8192, 8192, 128, true);
            epi::EpiResid E{XB, ssq_next, WSP(float, WS_SLAB)}; pg8::gemm_phase(lds, g, S, E);
        }
        PH_END();
        if (SITE(16) && PH_ON()) { SITE_LOCALS; CTX_LOCALS; thin::resid_finalize(C, WSP(float, WS_SLAB), XB, ssq_next); }
        PH_END();
    }
    if (SITE(14) && PH_ON()) for (int rep_ = 0; rep_ < REPS(14); ++rep_) { SITE_LOCALS; CTX_LOCALS; thin::final_norm(C, XB, SSQ + (size_t)8 * MT * 32, args.norm_final, out + O_YP, out + O_YS); }
    PH_END();
#undef PH_ON
#undef PH_END
}

#ifndef MEMSET_BYTES
#define MEMSET_BYTES CTL_BYTES
#endif
extern "C" void kernel_launch(void* const* d_in, const int* in_sizes, int n_in, void* d_out, int out_size, void* d_ws, size_t ws_size, hipStream_t stream) {
    static int grid = 0;
    if (grid == 0) {
        if (n_in != 21 || (size_t)out_size != O_END || ws_size < WS_END) { fprintf(stderr, "kernel_launch: unexpected shapes (n_in %d, out %d, ws %zu; need 21, %zu, >= %zu); nothing launched\n", n_in, out_size, ws_size, (size_t)O_END, (size_t)WS_END); grid = -1; return; }
        int dev = 0, cus = 0, per_cu = 0;
        if (hipGetDevice(&dev) != hipSuccess || hipDeviceGetAttribute(&cus, hipDeviceAttributeMultiprocessorCount, dev) != hipSuccess) { fprintf(stderr, "kernel_launch: device query failed\n"); grid = -1; return; }
        if (hipFuncSetAttribute((const void*)mk_fwd, hipFuncAttributeMaxDynamicSharedMemorySize, LDS_BYTES) != hipSuccess) { fprintf(stderr, "kernel_launch: hipFuncSetAttribute failed\n"); grid = -1; return; }
        if (hipOccupancyMaxActiveBlocksPerMultiprocessor(&per_cu, (const void*)mk_fwd, NWAVES * 64, LDS_BYTES) != hipSuccess || per_cu < 1) { fprintf(stderr, "kernel_launch: occupancy query reports %d workgroups per CU\n", per_cu); per_cu = 1; }
        (void)hipGetLastError();
        grid = cus;
    }
    if (grid < 0) return;
    (void)hipMemsetAsync((char*)d_ws + WS_CTL, 0, (size_t)MEMSET_BYTES, stream);
    Args a{};
    const float** pa = (const float**)&a;
    for (int i = 0; i < 21; ++i) pa[i] = (const float*)d_in[i];
    a.out = (float*)d_out; a.ws = (unsigned char*)d_ws;
#ifndef MK_CHECK
    a.ph_lo = 0; a.ph_hi = N_PHASES;
    hipLaunchKernelGGL(mk_fwd, dim3(grid), dim3(NWAVES * 64), LDS_BYTES, stream, a);
#else
    MK_CHECK_BODY
#endif
}
```
